# Optimizing an MI355X kernel written in HIP

```python
import math
import jax, jax.numpy as jnp
from jax import lax
import numpy as np

D_MODEL = 1024
BATCH = 8
SEQ = 4096
DEPTH = 2

MEM_LEN = 256
BLOCK_Q = 128
H_A = 8
DH_A = 64
DC_A = 128
H_IDX = 8
DH_IDX = 64
TOPK_MAX = 256
H_SB = 8
DH_SB = 64
C_CONV = 512
CONV_W = 3
W_A = H_A * DH_A
W_SB = H_SB * DH_SB
W_BRANCH = 512
N_BRANCH = 3
H_X = 4
DH_X = 128
D_FF = 2816
N_BUCKETS = 32
MAX_DISTANCE = 128
DN_ALPHA = (2 * DEPTH) ** 0.25
DN_BETA = (8 * DEPTH) ** -0.25
LN_EPS = 1e-5
N_LN = 4
SPLITS = (W_A, DC_A, H_IDX * DH_IDX, DH_IDX, H_IDX, W_SB, W_SB, W_SB,
          C_CONV, C_CONV, C_CONV, D_MODEL, D_MODEL, D_MODEL)
P_TOTAL = sum(SPLITS)

kernel_name = "hybrid_dsa_stickbreak_shortconv_gated"


def layer_norm(x, g, b):
    xf = x.astype(jnp.float32)
    mu = jnp.mean(xf, axis=-1, keepdims=True)
    var = jnp.mean(jnp.square(xf - mu), axis=-1, keepdims=True)
    y = (xf - mu) * lax.rsqrt(var + LN_EPS) * g.astype(jnp.float32) + b.astype(jnp.float32)
    return y.astype(x.dtype)


def rms_norm(x, g):
    xf = x.astype(jnp.float32)
    y = xf * lax.rsqrt(jnp.mean(jnp.square(xf), axis=-1, keepdims=True) + LN_EPS) * g.astype(jnp.float32)
    return y.astype(x.dtype)


def swiglu_ffn(x, w_in, w_out):
    a, b = jnp.split(x @ w_in, 2, axis=-1)
    return (jax.nn.silu(a) * b) @ w_out


def t5_bucket(n):
    max_exact = N_BUCKETS // 2
    n = jnp.maximum(n, 0)
    nf = jnp.maximum(n, 1).astype(jnp.float32)
    large = max_exact + (jnp.log(nf / max_exact) / math.log(MAX_DISTANCE / max_exact)
                         * (N_BUCKETS - max_exact)).astype(jnp.int32)
    large = jnp.minimum(large, N_BUCKETS - 1)
    return jnp.where(n < max_exact, n, large)


def dsa_branch(q, c_kv, iq, ik, iw, w_uk, w_uv, rel_bias):
    bsz, seq = q.shape[0], q.shape[1]
    k_top = min(TOPK_MAX, seq // 4)
    nblk = seq // BLOCK_Q
    q_lat = jnp.einsum('bshd,hdc->bshc', q, w_uk) * (DH_A ** -0.5)
    idx_scale = (H_IDX ** -0.5) * (DH_IDX ** -0.5)

    def to_blocks(a):
        return jnp.swapaxes(a.reshape((bsz, nblk, BLOCK_Q) + a.shape[2:]), 0, 1)

    starts = jnp.arange(nblk, dtype=jnp.int32) * BLOCK_Q
    key_pos = jnp.arange(seq, dtype=jnp.int32)

    def block(args):
        ql, iqb, iwb, start = args
        t = start + jnp.arange(BLOCK_Q, dtype=jnp.int32)
        causal = key_pos[None, :] <= t[:, None]
        dots = jnp.einsum('bqhd,bsd->bhqs', iqb, ik).astype(jnp.float32)
        score = jnp.einsum('bqh,bhqs->bqs', iwb.astype(jnp.float32) * idx_scale, jax.nn.relu(dots))
        score = jnp.where(causal[None], score, -jnp.inf)
        _, idx = lax.top_k(score, k_top)
        valid = idx <= t[None, :, None]
        kv_sel = jax.vmap(lambda c, i: c[i])(c_kv, idx)
        logits = jnp.einsum('bqhc,bqkc->bhqk', ql, kv_sel).astype(jnp.float32)
        bias = rel_bias[t5_bucket(t[None, :, None] - idx)]
        logits = logits + jnp.transpose(bias, (0, 3, 1, 2)).astype(jnp.float32)
        logits = jnp.where(valid[:, None], logits, -1e30)
        p = jax.nn.softmax(logits, axis=-1).astype(kv_sel.dtype)
        return jnp.einsum('bhqk,bqkc->bqhc', p, kv_sel)

    o_lat = lax.map(block, (to_blocks(q_lat), to_blocks(iq), to_blocks(iw), starts))
    o_lat = jnp.swapaxes(o_lat, 0, 1).reshape(bsz, seq, H_A, DC_A)
    o = jnp.einsum('bshc,hcd->bshd', o_lat, w_uv)
    return o.reshape(bsz, seq, W_A)


def stick_breaking_branch(q, k, v):
    bsz, seq = q.shape[0], q.shape[1]
    scale = DH_SB ** -0.5
    outs = []
    for i in range(seq // BLOCK_Q):
        q0 = i * BLOCK_Q
        end = q0 + BLOCK_Q
        z = jnp.einsum('bqhd,bshd->bhqs', q[:, q0:end], k[:, :end]).astype(jnp.float32) * scale
        t = q0 + jnp.arange(BLOCK_Q)
        s = jnp.arange(end)
        strict = (s[None, :] < t[:, None])[None, None]
        log_not = jnp.where(strict, jax.nn.log_sigmoid(-z), 0.0)
        later = lax.cumsum(log_not, axis=3, reverse=True) - log_not
        a = jnp.where(strict, jnp.exp(jax.nn.log_sigmoid(z) + later), 0.0)
        outs.append(jnp.einsum('bhqs,bshd->bqhd', a.astype(v.dtype), v[:, :end]))
    return jnp.concatenate(outs, axis=1).reshape(bsz, seq, W_SB)


def short_conv_branch(b_gate_in, c_gate_in, h, conv_w):
    z = c_gate_in * h
    y = lax.conv_general_dilated(z, conv_w[:, None, :].astype(z.dtype), window_strides=(1,),
                                 padding=((CONV_W - 1, 0),),
                                 dimension_numbers=('NWC', 'WIO', 'NWC'),
                                 feature_group_count=C_CONV)
    return b_gate_in * y


def mixer_sublayer(x, w_in, b_gate, kv_g, w_uk, w_uv, conv_w, w_branch, w_out, rel_bias):
    bsz, seq = x.shape[0], x.shape[1]
    offsets = [int(o) for o in np.cumsum(SPLITS)[:-1]]
    (qa, ckv, iq, ik, iw, qs, ks, vs, cb, cc, ch, ga, gb, gc) = jnp.split(x @ w_in, offsets, axis=-1)
    ckv = rms_norm(ckv, kv_g)
    y_a = dsa_branch(qa.reshape(bsz, seq, H_A, DH_A), ckv,
                     iq.reshape(bsz, seq, H_IDX, DH_IDX), ik, iw, w_uk, w_uv, rel_bias)
    hs = (bsz, seq, H_SB, DH_SB)
    y_b = stick_breaking_branch(qs.reshape(hs), ks.reshape(hs), vs.reshape(hs))
    y_c = short_conv_branch(cb, cc, ch, conv_w)
    merged = (jax.nn.sigmoid(ga + b_gate[0]) * (y_a @ w_branch[0])
              + jax.nn.sigmoid(gb + b_gate[1]) * (y_b @ w_branch[1])
              + jax.nn.sigmoid(gc + b_gate[2]) * (y_c @ w_branch[2]))
    return merged @ w_out


def memory_cross_attention(x, mem, wq, wkv, wo):
    bsz, seq = x.shape[0], x.shape[1]
    q = (x @ wq).reshape(bsz, seq, H_X, DH_X)
    k, v = jnp.split(mem @ wkv, 2, axis=-1)
    k = k.reshape(bsz, mem.shape[1], H_X, DH_X)
    v = v.reshape(bsz, mem.shape[1], H_X, DH_X)
    logits = jnp.einsum('bqhd,bmhd->bhqm', q, k).astype(jnp.float32) * (DH_X ** -0.5)
    p = jax.nn.softmax(logits, axis=-1).astype(v.dtype)
    o = jnp.einsum('bhqm,bmhd->bqhd', p, v).reshape(bsz, seq, H_X * DH_X)
    return o @ wo


def setup_inputs(seed: int = 0) -> dict:
    key = jax.random.key(seed)
    ks = jax.random.split(key, 20)
    n = jax.random.normal
    f32 = jnp.float32
    return {
        "x": n(ks[0], (BATCH, SEQ, D_MODEL), f32),
        "mem": n(ks[1], (BATCH, MEM_LEN, D_MODEL), f32),
        "ln_g": 1.0 + 0.01 * n(ks[2], (DEPTH, N_LN, D_MODEL), f32),
        "ln_b": 0.01 * n(ks[3], (DEPTH, N_LN, D_MODEL), f32),
        "ffn_w_in": n(ks[4], (DEPTH, 2, D_MODEL, 2 * D_FF), f32) * D_MODEL ** -0.5,
        "ffn_w_out": n(ks[5], (DEPTH, 2, D_FF, D_MODEL), f32) * (D_FF ** -0.5 * DN_BETA),
        "w_mix_in": n(ks[6], (DEPTH, D_MODEL, P_TOTAL), f32) * D_MODEL ** -0.5,
        "b_gate": 0.01 * n(ks[7], (DEPTH, N_BRANCH, D_MODEL), f32),
        "kv_norm_g": 1.0 + 0.01 * n(ks[8], (DEPTH, DC_A), f32),
        "w_uk": n(ks[9], (DEPTH, H_A, DH_A, DC_A), f32) * DH_A ** -0.5,
        "w_uv": n(ks[10], (DEPTH, H_A, DC_A, DH_A), f32) * DC_A ** -0.5,
        "conv_w": n(ks[11], (DEPTH, CONV_W, C_CONV), f32) * CONV_W ** -0.5,
        "w_branch": n(ks[12], (DEPTH, N_BRANCH, W_BRANCH, D_MODEL), f32) * W_BRANCH ** -0.5,
        "w_mix_out": n(ks[13], (DEPTH, D_MODEL, D_MODEL), f32) * (D_MODEL ** -0.5 * DN_BETA),
        "xa_wq": n(ks[14], (DEPTH, D_MODEL, H_X * DH_X), f32) * D_MODEL ** -0.5,
        "xa_wkv": n(ks[15], (DEPTH, D_MODEL, 2 * H_X * DH_X), f32) * D_MODEL ** -0.5,
        "xa_wo": n(ks[16], (DEPTH, H_X * DH_X, D_MODEL), f32) * ((H_X * DH_X) ** -0.5 * DN_BETA),
        "rel_bias": 0.1 * n(ks[17], (N_BUCKETS, H_A), f32),
    }


def reference(x, mem, ln_g, ln_b, ffn_w_in, ffn_w_out, w_mix_in, b_gate, kv_norm_g, w_uk, w_uv,
              conv_w, w_branch, w_mix_out, xa_wq, xa_wkv, xa_wo, rel_bias):
    for l in range(DEPTH):
        x = layer_norm(DN_ALPHA * x + 0.5 * swiglu_ffn(x, ffn_w_in[l, 0], ffn_w_out[l, 0]),
                       ln_g[l, 0], ln_b[l, 0])
        x = layer_norm(DN_ALPHA * x + mixer_sublayer(x, w_mix_in[l], b_gate[l], kv_norm_g[l], w_uk[l],
                                                     w_uv[l], conv_w[l], w_branch[l], w_mix_out[l],
                                                     rel_bias),
                       ln_g[l, 1], ln_b[l, 1])
        x = layer_norm(DN_ALPHA * x + memory_cross_attention(x, mem, xa_wq[l], xa_wkv[l], xa_wo[l]),
                       ln_g[l, 2], ln_b[l, 2])
        x = layer_norm(DN_ALPHA * x + 0.5 * swiglu_ffn(x, ffn_w_in[l, 1], ffn_w_out[l, 1]),
                       ln_g[l, 3], ln_b[l, 3])
    return x
```

```cpp
#include <hip/hip_runtime.h>
#include <cstdio>
#include <cstdint>

namespace nv {
constexpr int D = 1024, B = 8, S = 4096, DEPTH = 2, MEM = 256, DFF = 2816, PT = 7368;
constexpr int O_QA = 0, O_CKV = 512, O_IQ = 640, O_IK = 1152, O_IW = 1216, O_QS = 1224, O_KS = 1736, O_VS = 2248, O_CB = 2760, O_CC = 3272, O_CH = 3784, O_GA = 4296;
constexpr float ALPHA = 1.4142135623730951f, EPS = 1e-5f;

struct T5Tab { unsigned char v[128]; };
constexpr T5Tab make_t5() {
    T5Tab t{};
    for (int n = 0; n < 128; ++n) {
        if (n < 16) { t.v[n] = (unsigned char)n; continue; }
        unsigned __int128 p = 1; for (int i = 0; i < 16; ++i) p *= (unsigned __int128)n;
        int k = 0; for (int kk = 0; kk <= 15; ++kk) { if (p >= ((unsigned __int128)1 << (3 * kk + 64))) k = kk; }
        int bk = 16 + k; if (bk > 31) bk = 31; t.v[n] = (unsigned char)bk;
    }
    return t;
}
__device__ const T5Tab T5 = make_t5();

template <bool TRANSB>
__global__ __launch_bounds__(256) void k_sgemm(const float* A, int lda, long sA, const float* Bm, int ldb, long sB, float* C, int ldc, long sC, int M, int N, int K) {
    __shared__ float As[16][68], Bs[16][68];
    A += (long)blockIdx.z * sA; Bm += (long)blockIdx.z * sB; C += (long)blockIdx.z * sC;
    const int tid = threadIdx.x, tx = tid & 15, ty = tid >> 4, m0 = blockIdx.y * 64, n0 = blockIdx.x * 64;
    float acc[4][4];
#pragma unroll
    for (int i = 0; i < 4; ++i)
#pragma unroll
        for (int j = 0; j < 4; ++j) acc[i][j] = 0.f;
    for (int k0 = 0; k0 < K; k0 += 16) {
        { const int r = tid >> 2, c4 = (tid & 3) * 4; const float4 v = *(const float4*)(A + (long)(m0 + r) * lda + k0 + c4);
          As[c4 + 0][r] = v.x; As[c4 + 1][r] = v.y; As[c4 + 2][r] = v.z; As[c4 + 3][r] = v.w; }
        if (!TRANSB) { const int r = tid >> 4, c4 = (tid & 15) * 4;
#pragma unroll
            for (int j = 0; j < 4; ++j) { const int n = n0 + c4 + j; Bs[r][c4 + j] = n < N ? Bm[(long)(k0 + r) * ldb + n] : 0.f; } }
        else { const int r = tid >> 2, c4 = (tid & 3) * 4; const int n = n0 + r;
            float4 v = make_float4(0.f, 0.f, 0.f, 0.f); if (n < N) v = *(const float4*)(Bm + (long)n * ldb + k0 + c4);
            Bs[c4 + 0][r] = v.x; Bs[c4 + 1][r] = v.y; Bs[c4 + 2][r] = v.z; Bs[c4 + 3][r] = v.w; }
        __syncthreads();
#pragma unroll
        for (int kk = 0; kk < 16; ++kk) {
            const float4 a = *(const float4*)&As[kk][ty * 4]; const float4 b = *(const float4*)&Bs[kk][tx * 4];
            const float av[4] = {a.x, a.y, a.z, a.w}, bv[4] = {b.x, b.y, b.z, b.w};
#pragma unroll
            for (int i = 0; i < 4; ++i)
#pragma unroll
                for (int j = 0; j < 4; ++j) acc[i][j] += av[i] * bv[j];
        }
        __syncthreads();
    }
#pragma unroll
    for (int i = 0; i < 4; ++i)
#pragma unroll
        for (int j = 0; j < 4; ++j) { const int n = n0 + tx * 4 + j; if (n < N) C[(long)(m0 + ty * 4 + i) * ldc + n] = acc[i][j]; }
}

__device__ __forceinline__ float wsum(float v) {
#pragma unroll
    for (int o = 1; o < 64; o <<= 1) v += __shfl_xor(v, o);
    return v;
}
__device__ __forceinline__ float wmax(float v) {
#pragma unroll
    for (int o = 1; o < 64; o <<= 1) v = fmaxf(v, __shfl_xor(v, o));
    return v;
}
__global__ __launch_bounds__(256) void k_res_ln(const float* x, const float* y, float s, const float* g, const float* b, float* out, int rows) {
    const int row = blockIdx.x * 4 + (threadIdx.x >> 6), lane = threadIdx.x & 63; if (row >= rows) return;
    float v[16]; float sum = 0.f;
#pragma unroll
    for (int j = 0; j < 16; ++j) { const int c = j * 64 + lane; v[j] = ALPHA * x[(long)row * D + c] + s * y[(long)row * D + c]; sum += v[j]; }
    const float mean = wsum(sum) * (1.f / D); float q = 0.f;
#pragma unroll
    for (int j = 0; j < 16; ++j) { v[j] -= mean; q += v[j] * v[j]; }
    const float rstd = rsqrtf(wsum(q) * (1.f / D) + EPS);
#pragma unroll
    for (int j = 0; j < 16; ++j) { const int c = j * 64 + lane; out[(long)row * D + c] = v[j] * rstd * g[c] + b[c]; }
}
__global__ void k_swiglu(const float* G, float* H, int rows) {
    const long i = (long)blockIdx.x * blockDim.x + threadIdx.x; if (i >= (long)rows * DFF) return;
    const long r = i / DFF; const int c = (int)(i % DFF); const float a = G[r * (2 * DFF) + c], bb = G[r * (2 * DFF) + DFF + c];
    H[i] = a / (1.f + expf(-a)) * bb;
}
__global__ __launch_bounds__(256) void k_rms(const float* T1, const float* g, float* out, int rows) {
    const int row = blockIdx.x * 4 + (threadIdx.x >> 6), lane = threadIdx.x & 63; if (row >= rows) return;
    const float a = T1[(long)row * PT + O_CKV + lane], b = T1[(long)row * PT + O_CKV + 64 + lane];
    const float r = rsqrtf(wsum(a * a + b * b) * (1.f / 128.f) + EPS);
    out[(long)row * 128 + lane] = a * r * g[lane]; out[(long)row * 128 + 64 + lane] = b * r * g[64 + lane];
}
__global__ void k_acc1(const float* T1, const float* DOTS, float* SC, int h) {
    const long i = (long)blockIdx.x * blockDim.x + threadIdx.x; if (i >= (long)S * S) return;
    const int t = (int)(i / S); const float scale = 0.35355339059327373f * 0.125f;
    const float v = T1[(long)t * PT + O_IW + h] * scale * fmaxf(DOTS[i], 0.f);
    SC[i] = h == 0 ? v : SC[i] + v;
}
__device__ __forceinline__ unsigned f2ord(float f) { const unsigned u = __float_as_uint(f); return (u & 0x80000000u) ? ~u : (u | 0x80000000u); }
__global__ __launch_bounds__(256) void k_topk(const float* SC, int* IDX) {
    const int t = blockIdx.x * 4 + (threadIdx.x >> 6), lane = threadIdx.x & 63; if (t >= S) return;
    unsigned u[64];
#pragma unroll
    for (int j = 0; j < 64; ++j) { const int s = j * 64 + lane; const float f = s <= t ? SC[(long)t * S + s] : -INFINITY; u[j] = f2ord(f); }
    unsigned T = 0;
    for (int bit = 31; bit >= 0; --bit) {
        const unsigned cand = T | (1u << bit); int c = 0;
#pragma unroll
        for (int j = 0; j < 64; ++j) c += __builtin_popcountll(__ballot(u[j] >= cand));
        if (c >= 256) T = cand;
    }
    int cgt = 0;
#pragma unroll
    for (int j = 0; j < 64; ++j) cgt += __builtin_popcountll(__ballot(u[j] > T));
    int need = 256 - cgt, base = 0;
#pragma unroll
    for (int j = 0; j < 64; ++j) {
        const unsigned long long mgt = __ballot(u[j] > T), meq = __ballot(u[j] == T);
        const unsigned long long below = (1ull << lane) - 1ull;
        const int eqrank = __builtin_popcountll(meq & below); const bool take_eq = (u[j] == T) && (eqrank < need);
        const unsigned long long msel = mgt | __ballot(take_eq);
        const int neq = __builtin_popcountll(meq); need -= neq < need ? neq : need;
        if ((msel >> lane) & 1ull) IDX[(long)t * 256 + base + __builtin_popcountll(msel & below)] = j * 64 + lane;
        base += __builtin_popcountll(msel);
    }
}
__global__ __launch_bounds__(256) void k_dsa_attn(const float* QLAT, const float* CKVN, const int* IDX, const float* rel_bias, float* OLAT) {
    __shared__ float q[1024]; __shared__ float P[8][256]; __shared__ int keys[256]; __shared__ float red[8];
    const int t = blockIdx.x, tid = threadIdx.x, lane = tid & 63, w = tid >> 6;
    for (int i = tid; i < 1024; i += 256) q[i] = QLAT[(long)t * 1024 + i];
    const int key = IDX[(long)t * 256 + tid]; keys[tid] = key;
    __syncthreads();
    const bool valid = key <= t; const int kk = valid ? key : 0; const int dist = t - kk; const int bucket = dist < 128 ? (int)T5.v[dist < 0 ? 0 : dist] : 31;
    float lg[8];
#pragma unroll
    for (int h = 0; h < 8; ++h) lg[h] = 0.f;
    for (int c = 0; c < 128; c += 4) { const float4 kv = *(const float4*)(CKVN + (long)kk * 128 + c);
#pragma unroll
        for (int h = 0; h < 8; ++h) lg[h] += q[h * 128 + c] * kv.x + q[h * 128 + c + 1] * kv.y + q[h * 128 + c + 2] * kv.z + q[h * 128 + c + 3] * kv.w; }
#pragma unroll
    for (int h = 0; h < 8; ++h) {
        float l = lg[h] * 0.125f + rel_bias[bucket * 8 + h]; if (!valid) l = -1e30f;
        float m = wmax(l); if (lane == 0) red[w] = m; __syncthreads(); m = fmaxf(fmaxf(red[0], red[1]), fmaxf(red[2], red[3])); __syncthreads();
        const float e = expf(l - m); float sum = wsum(e); if (lane == 0) red[4 + w] = sum; __syncthreads(); sum = red[4] + red[5] + red[6] + red[7]; __syncthreads();
        P[h][tid] = e / sum;
    }
    __syncthreads();
    for (int o = tid; o < 1024; o += 256) { const int h = o >> 7, c = o & 127; float acc = 0.f;
        for (int k = 0; k < 256; ++k) { const int ky = keys[k]; if (ky <= t) acc += P[h][k] * CKVN[(long)ky * 128 + c]; }
        OLAT[(long)t * 1024 + o] = acc; }
}
__global__ __launch_bounds__(256) void k_sb_weights(float* Z, float zscale) {
    const int t = blockIdx.x * 4 + (threadIdx.x >> 6), lane = threadIdx.x & 63; if (t >= S) return;
    float* row = Z + (long)t * S;
    float carry = 0.f;
    for (int ch = S / 64 - 1; ch >= 0; --ch) {
        const int s = ch * 64 + lane;
        if (ch * 64 >= t) { row[s] = 0.f; continue; }
        const bool ok = s < t;
        const float z = row[s] * zscale;
        const float sp = ok ? fmaxf(z, 0.f) + log1pf(expf(-fabsf(z))) : 0.f;
        float v = -sp;
#pragma unroll
        for (int o = 1; o < 64; o <<= 1) { const float n = __shfl_down(v, o); if (lane + o < 64) v += n; }
        const float later = carry + (v + sp);
        row[s] = ok ? expf((z - sp) + later) : 0.f;
        carry += __shfl(v, 0);
    }
}
__global__ void k_conv(const float* T1, const float* cw, float* YC) {
    const long i = (long)blockIdx.x * blockDim.x + threadIdx.x; if (i >= (long)S * 512) return;
    const int t = (int)(i / 512), c = (int)(i % 512); float acc = 0.f;
#pragma unroll
    for (int j = 0; j < 3; ++j) { const int tt = t - 2 + j; if (tt >= 0) acc += cw[j * 512 + c] * T1[(long)tt * PT + O_CC + c] * T1[(long)tt * PT + O_CH + c]; }
    YC[i] = T1[(long)t * PT + O_CB + c] * acc;
}
__global__ void k_merge(const float* T1, const float* bg, const float* P, float* Mg) {
    const long i = (long)blockIdx.x * blockDim.x + threadIdx.x; if (i >= (long)S * D) return;
    const int t = (int)(i / D), c = (int)(i % D); float acc = 0.f;
#pragma unroll
    for (int k = 0; k < 3; ++k) { const float g = T1[(long)t * PT + O_GA + k * D + c] + bg[k * D + c]; acc += P[(long)k * S * D + i] / (1.f + expf(-g)); }
    Mg[i] = acc;
}
__global__ __launch_bounds__(256) void k_xattn(const float* Q, const float* KV, float* O) {
    __shared__ float q[512]; __shared__ float P[4][256]; __shared__ float red[8];
    const int t = blockIdx.x, tid = threadIdx.x, lane = tid & 63, w = tid >> 6;
    for (int i = tid; i < 512; i += 256) q[i] = Q[(long)t * 512 + i];
    __syncthreads();
#pragma unroll
    for (int h = 0; h < 4; ++h) {
        float l = 0.f; for (int d = 0; d < 128; ++d) l += q[h * 128 + d] * KV[(long)tid * 1024 + h * 128 + d];
        l *= 0.08838834764831845f;
        float m = wmax(l); if (lane == 0) red[w] = m; __syncthreads(); m = fmaxf(fmaxf(red[0], red[1]), fmaxf(red[2], red[3])); __syncthreads();
        const float e = expf(l - m); float sum = wsum(e); if (lane == 0) red[4 + w] = sum; __syncthreads(); sum = red[4] + red[5] + red[6] + red[7]; __syncthreads();
        P[h][tid] = e / sum;
    }
    __syncthreads();
    for (int o = tid; o < 512; o += 256) { const int h = o >> 7; float acc = 0.f;
        for (int m = 0; m < 256; ++m) acc += P[h][m] * KV[(long)m * 1024 + 512 + o];
        O[(long)t * 512 + o] = acc; }
}
__global__ void k_copy(const float* a, float* b, long n) { const long i = (long)blockIdx.x * blockDim.x + threadIdx.x; if (i < n) b[i] = a[i]; }
}

static void sgemm(hipStream_t st, bool transb, const float* A, int lda, long sA, const float* Bm, int ldb, long sB, float* C, int ldc, long sC, int M, int N, int K, int Z) {
    dim3 g((N + 63) / 64, M / 64, Z);
    if (transb) hipLaunchKernelGGL(nv::k_sgemm<true>, g, dim3(256), 0, st, A, lda, sA, Bm, ldb, sB, C, ldc, sC, M, N, K);
    else hipLaunchKernelGGL(nv::k_sgemm<false>, g, dim3(256), 0, st, A, lda, sA, Bm, ldb, sB, C, ldc, sC, M, N, K);
}

extern "C" void kernel_launch(void* const* d_in, const int* in_sizes, int n_in, void* d_out, int out_size, void* d_ws, size_t ws_size, hipStream_t st) {
    using namespace nv;
    const float* x_in = (const float*)d_in[0]; const float* mem = (const float*)d_in[1]; const float* ln_g = (const float*)d_in[2]; const float* ln_b = (const float*)d_in[3];
    const float* ffn_w_in = (const float*)d_in[4]; const float* ffn_w_out = (const float*)d_in[5]; const float* w_mix_in = (const float*)d_in[6]; const float* b_gate = (const float*)d_in[7];
    const float* kv_g = (const float*)d_in[8]; const float* w_uk = (const float*)d_in[9]; const float* w_uv = (const float*)d_in[10]; const float* conv_w = (const float*)d_in[11];
    const float* w_branch = (const float*)d_in[12]; const float* w_mix_out = (const float*)d_in[13]; const float* xa_wq = (const float*)d_in[14]; const float* xa_wkv = (const float*)d_in[15];
    const float* xa_wo = (const float*)d_in[16]; const float* rel_bias = (const float*)d_in[17];
    float* X = (float*)d_out;
    char* w = (char*)d_ws; size_t off = 0;
    auto take = [&](size_t bytes) { float* p = (float*)(w + off); off += (bytes + 255) & ~(size_t)255; return p; };
    float* T1 = take((size_t)S * PT * 4);
    float* H = take((size_t)S * DFF * 4);
    float* Y = take((size_t)S * D * 4);
    float* BIG = take((size_t)S * S * 4);
    float* SC = take((size_t)S * S * 4);
    float* CKVN = take((size_t)S * 128 * 4);
    float* QLAT = take((size_t)S * 1024 * 4);
    float* OLAT = take((size_t)S * 1024 * 4);
    int* IDX = (int*)take((size_t)S * 256 * 4);
    float* YABC = take((size_t)3 * S * 512 * 4);
    float* P3 = take((size_t)3 * S * D * 4);
    float* MG = take((size_t)S * D * 4);
    float* XQ = take((size_t)S * 512 * 4);
    float* XO = take((size_t)S * 512 * 4);
    float* MKV = take((size_t)MEM * 1024 * 4);
    if (off > ws_size) { fprintf(stderr, "ws too small: need %zu have %zu\n", off, ws_size); return; }
    const long NX = (long)B * S * D;
    hipLaunchKernelGGL(k_copy, dim3((unsigned)((NX + 255) / 256)), dim3(256), 0, st, x_in, X, NX);
    auto ffn = [&](int l, int which, int lnidx) {
        const float* win = ffn_w_in + (size_t)(l * 2 + which) * D * 2 * DFF; const float* wout = ffn_w_out + (size_t)(l * 2 + which) * DFF * D;
        for (int b = 0; b < B; ++b) { float* xb = X + (size_t)b * S * D;
            sgemm(st, false, xb, D, 0, win, 2 * DFF, 0, T1, 2 * DFF, 0, S, 2 * DFF, D, 1);
            hipLaunchKernelGGL(k_swiglu, dim3((unsigned)(((long)S * DFF + 255) / 256)), dim3(256), 0, st, T1, H, S);
            sgemm(st, false, H, DFF, 0, wout, D, 0, Y, D, 0, S, D, DFF, 1);
            hipLaunchKernelGGL(k_res_ln, dim3(S / 4), dim3(256), 0, st, xb, Y, 0.5f, ln_g + (size_t)(l * 4 + lnidx) * D, ln_b + (size_t)(l * 4 + lnidx) * D, xb, S); }
    };
    for (int l = 0; l < DEPTH; ++l) {
        ffn(l, 0, 0);
        for (int b = 0; b < B; ++b) { float* xb = X + (size_t)b * S * D;
            sgemm(st, false, xb, D, 0, w_mix_in + (size_t)l * D * PT, PT, 0, T1, PT, 0, S, PT, D, 1);
            hipLaunchKernelGGL(k_rms, dim3(S / 4), dim3(256), 0, st, T1, kv_g + (size_t)l * 128, CKVN, S);
            sgemm(st, false, T1 + O_QA, PT, 64, w_uk + (size_t)l * 8 * 64 * 128, 128, 64 * 128, QLAT, 1024, 128, S, 128, 64, 8);
            for (int h = 0; h < 8; ++h) {
                sgemm(st, true, T1 + O_IQ + h * 64, PT, 0, T1 + O_IK, PT, 0, BIG, S, 0, S, S, 64, 1);
                hipLaunchKernelGGL(k_acc1, dim3((unsigned)(((long)S * S + 255) / 256)), dim3(256), 0, st, (const float*)T1, (const float*)BIG, SC, h);
            }
            hipLaunchKernelGGL(k_topk, dim3(S / 4), dim3(256), 0, st, SC, IDX);
            hipLaunchKernelGGL(k_dsa_attn, dim3(S), dim3(256), 0, st, QLAT, CKVN, IDX, rel_bias, OLAT);
            sgemm(st, false, OLAT, 1024, 128, w_uv + (size_t)l * 8 * 128 * 64, 64, 128 * 64, YABC, 512, 64, S, 64, 128, 8);
            for (int h = 0; h < 8; ++h) {
                sgemm(st, true, T1 + O_QS + h * 64, PT, 0, T1 + O_KS + h * 64, PT, 0, BIG, S, 0, S, S, 64, 1);
                hipLaunchKernelGGL(k_sb_weights, dim3(S / 4), dim3(256), 0, st, BIG, 0.125f);
                sgemm(st, false, BIG, S, 0, T1 + O_VS + h * 64, PT, 0, YABC + (size_t)S * 512 + h * 64, 512, 0, S, 64, S, 1);
            }
            hipLaunchKernelGGL(k_conv, dim3((unsigned)(((long)S * 512 + 255) / 256)), dim3(256), 0, st, T1, conv_w + (size_t)l * 3 * 512, YABC + (size_t)2 * S * 512);
            sgemm(st, false, YABC, 512, (long)S * 512, w_branch + (size_t)l * 3 * 512 * D, D, (long)512 * D, P3, D, (long)S * D, S, D, 512, 3);
            hipLaunchKernelGGL(k_merge, dim3((unsigned)(((long)S * D + 255) / 256)), dim3(256), 0, st, T1, b_gate + (size_t)l * 3 * D, P3, MG);
            sgemm(st, false, MG, D, 0, w_mix_out + (size_t)l * D * D, D, 0, Y, D, 0, S, D, D, 1);
            hipLaunchKernelGGL(k_res_ln, dim3(S / 4), dim3(256), 0, st, xb, Y, 1.0f, ln_g + (size_t)(l * 4 + 1) * D, ln_b + (size_t)(l * 4 + 1) * D, xb, S);
        }
        for (int b = 0; b < B; ++b) { float* xb = X + (size_t)b * S * D;
            sgemm(st, false, xb, D, 0, xa_wq + (size_t)l * D * 512, 512, 0, XQ, 512, 0, S, 512, D, 1);
            sgemm(st, false, mem + (size_t)b * MEM * D, D, 0, xa_wkv + (size_t)l * D * 1024, 1024, 0, MKV, 1024, 0, MEM, 1024, D, 1);
            hipLaunchKernelGGL(k_xattn, dim3(S), dim3(256), 0, st, XQ, MKV, XO);
            sgemm(st, false, XO, 512, 0, xa_wo + (size_t)l * 512 * D, D, 0, Y, D, 0, S, D, 512, 1);
            hipLaunchKernelGGL(k_res_ln, dim3(S / 4), dim3(256), 0, st, xb, Y, 1.0f, ln_g + (size_t)(l * 4 + 2) * D, ln_b + (size_t)(l * 4 + 2) * D, xb, S);
        }
        ffn(l, 1, 3);
    }
}
```

```cpp
#define MK_N_LAUNCHES 1
#include <hip/hip_runtime.h>
#include <cstdio>
#include <cstdint>

#define LAS __attribute__((address_space(3)))
#define GAS __attribute__((address_space(1)))
typedef _Float16 half_t;
typedef _Float16 h8 __attribute__((ext_vector_type(8)));
typedef _Float16 h4 __attribute__((ext_vector_type(4)));
typedef _Float16 h2 __attribute__((ext_vector_type(2)));
typedef float f32x4 __attribute__((ext_vector_type(4)));
typedef float f32x16 __attribute__((ext_vector_type(16)));
typedef short s4v __attribute__((ext_vector_type(4)));
typedef short s8v __attribute__((ext_vector_type(8)));
typedef unsigned u32x4 __attribute__((ext_vector_type(4)));
typedef unsigned u32x2 __attribute__((ext_vector_type(2)));

constexpr int D = 1024, NB = 8, S = 4096, DEPTH = 2, MEM = 256, DFF = 2816, PT = 7368;
constexpr int M = NB * S;
constexpr int CH_ROWS = 16384, NCHUNK = 2, CH_B = 4;
constexpr int NMIX = 7936;
constexpr int O_QA = 0, O_CKV = 512, O_IQ = 640, O_IK = 1152, O_IW = 1216, O_QS = 1224, O_KS = 1736, O_VS = 2248, O_CB = 2760, O_CC = 3272, O_CH = 3784, O_GA = 4296;
constexpr int C_QL = 0, C_IQ = 1024, C_QS = 1536, C_KS = 2048, C_VS = 2560, C_CB = 3072, C_CC = 3584, C_CH = 4096, C_G = 4608, C_CKV = 7680, C_IK = 7808, C_IW = 7872;
constexpr float ALPHA = 1.4142135623730951f, LN_EPS = 1e-5f, LOG2E = 1.4426950408889634f;

struct T5Tab { unsigned char v[128]; };
constexpr T5Tab make_t5() {
    T5Tab t{};
    for (int n = 0; n < 128; ++n) {
        if (n < 16) { t.v[n] = (unsigned char)n; continue; }
        unsigned __int128 p = 1; for (int i = 0; i < 16; ++i) p *= (unsigned __int128)n;
        int k = 0; for (int kk = 0; kk <= 15; ++kk) { if (p >= ((unsigned __int128)1 << (3 * kk + 64))) k = kk; }
        int bk = 16 + k; if (bk > 31) bk = 31; t.v[n] = (unsigned char)bk;
    }
    return t;
}
__device__ const T5Tab T5 = make_t5();

constexpr size_t MiB = 1u << 20;
constexpr size_t WS_CTL = 0, CTL_ZERO_BYTES = 1 * MiB;
constexpr size_t WS_WFIN = 1 * MiB;
constexpr size_t WS_WFOUT = WS_WFIN + 22 * MiB;
constexpr size_t WS_WMIX = WS_WFOUT + 11 * MiB;
constexpr size_t WS_WBRA = WS_WMIX + 16 * MiB;
constexpr size_t WS_WBRB = WS_WBRA + 2 * MiB;
constexpr size_t WS_WBRC = WS_WBRB + 1 * MiB;
constexpr size_t WS_WMO = WS_WBRC + 1 * MiB;
constexpr size_t WS_WXQ = WS_WMO + 2 * MiB;
constexpr size_t WS_WXKV = WS_WXQ + 1 * MiB;
constexpr size_t WS_WXO = WS_WXKV + 2 * MiB;
constexpr size_t WS_MEMH = WS_WXO + 1 * MiB;
constexpr size_t WS_MEMP = WS_MEMH + 4 * MiB;
constexpr size_t WS_BIAS = WS_MEMP + 4 * MiB;
constexpr size_t WS_XK = WS_BIAS + 1 * MiB;
constexpr size_t WS_XVT = WS_XK + 2 * MiB;
constexpr size_t WS_X = WS_XVT + 2 * MiB;
constexpr size_t WS_CKVN = WS_X + 64 * MiB;
constexpr size_t WS_IDX = WS_CKVN + 4 * MiB;
constexpr size_t WS_SCR = WS_IDX + 8 * MiB;
constexpr size_t WS_BIG = WS_SCR + 64 * MiB;
constexpr size_t WS_END = WS_BIG + 248 * MiB;
static_assert(WS_END <= 512 * MiB, "workspace map");
constexpr size_t DO_YA = 0, DO_YB = 32 * MiB, DO_YC = 48 * MiB, DO_MG = 64 * MiB;
constexpr int CW_BAR = 4096;

constexpr int RING_BYTES = 131072, LDSCTL_OFF = RING_BYTES, MISC_OFF = LDSCTL_OFF + 320, LDS_BYTES = 147456;
constexpr int NWAVES = 8;

#define LDS_WAIT() asm volatile("s_waitcnt lgkmcnt(0)" ::: "memory")
#define VM_WAIT() asm volatile("s_waitcnt vmcnt(0)" ::: "memory")
#define CFENCE() asm volatile("" ::: "memory")

__device__ __forceinline__ h8 pack8(float a0, float a1, float a2, float a3, float a4, float a5, float a6, float a7) {
    h8 r; r[0] = (half_t)a0; r[1] = (half_t)a1; r[2] = (half_t)a2; r[3] = (half_t)a3; r[4] = (half_t)a4; r[5] = (half_t)a5; r[6] = (half_t)a6; r[7] = (half_t)a7; return r;
}
__device__ __forceinline__ h4 pack4(float a0, float a1, float a2, float a3) { h4 r; r[0] = (half_t)a0; r[1] = (half_t)a1; r[2] = (half_t)a2; r[3] = (half_t)a3; return r; }
__device__ __forceinline__ int opaque_tid() { int x = (int)threadIdx.x; asm volatile("" : "+v"(x)); return x; }
__device__ __forceinline__ float ex2(float x) { return __builtin_amdgcn_exp2f(x); }
__device__ __forceinline__ float lg2(float x) { return __builtin_amdgcn_logf(x); }

namespace pg8 {
constexpr int BM = 256, BK = 64, HALF = 128, HTB = HALF * BK * 2, STAGE_BYTES = 8 * HTB, NXCD = 8, WGM = 8;
__host__ __device__ __forceinline__ int lds_byte(int r, int c) { const int st = (r >> 4) * 2 + (c >> 5), rr = r & 15, cc = c & 31, ob = rr * 64 + cc * 2; return st * 1024 + (ob ^ (((ob >> 9) & 1) << 5)); }
__host__ __device__ __forceinline__ void stage_rc(int b, int& R, int& C) { const int st = b / 1024, sb = b % 1024, swz = sb ^ (((sb >> 9) & 1) << 5); R = (st >> 1) * 16 + swz / 64; C = (st & 1) * 32 + (swz % 64) / 2; }
__host__ __device__ __forceinline__ int perm32(int rho) { const int n = rho >> 4, i = rho & 15; return 8 * (i >> 2) + 4 * n + (i & 3); }
struct Unit { int pm, pn; };
struct Gemm { const half_t* A; const half_t* Bt; int M, N, K; };
struct StaticOrder {
    int nM, nN, nwg, G, c;
    __host__ __device__ void init(int M_, int N_, int G_, int c_) { nM = M_ / BM; nN = N_ / BM; nwg = nM * nN; G = G_; c = c_; }
    __host__ __device__ bool next(int i, Unit& u) const {
        const long L = (long)i * G + c; if (L >= nwg) return false;
        int wgid = (int)L; { const int q = nwg / NXCD, r = nwg % NXCD, xcd = wgid % NXCD, off = wgid / NXCD; wgid = (xcd < r ? xcd * (q + 1) : r * (q + 1) + (xcd - r) * q) + off; }
        const int nig = WGM * nN, gid = wgid / nig, fm = gid * WGM, gsz = (nM - fm) < WGM ? (nM - fm) : WGM;
        u.pm = fm + ((wgid % nig) % gsz); u.pn = (wgid % nig) / gsz; return true;
    }
    __device__ __forceinline__ void a_ready(const Unit&) const {}
    __device__ __forceinline__ void done(const Unit&) const {}
};
typedef f32x4 Acc[2][2][4][2];

struct EpiH {
    half_t* O; int ldc; const float* bias; int sig_lo, sig_hi;
    __device__ __forceinline__ void operator()(const Acc& acc, const Unit& u, int wr, int wc, int fr, int fq) const {
        const int row0 = u.pm * BM + wr * 64 + fr, col0 = u.pn * BM + wc * 32 + 8 * fq;
        const bool sig = u.pn >= sig_lo && u.pn < sig_hi;
        f32x4 bv[2][2];
#pragma unroll
        for (int bj = 0; bj < 2; ++bj)
#pragma unroll
            for (int n = 0; n < 2; ++n) bv[bj][n] = bias ? *(const f32x4*)(bias + col0 + bj * HALF + 4 * n) : (f32x4){0.f, 0.f, 0.f, 0.f};
#pragma unroll
        for (int ai = 0; ai < 2; ++ai)
#pragma unroll
            for (int m = 0; m < 4; ++m) { half_t* rowp = O + (size_t)(row0 + ai * HALF + m * 16) * ldc + col0;
#pragma unroll
                for (int bj = 0; bj < 2; ++bj) { f32x4 v0 = acc[ai][bj][m][0] + bv[bj][0], v1 = acc[ai][bj][m][1] + bv[bj][1];
                    if (sig) {
#pragma unroll
                        for (int j = 0; j < 4; ++j) { v0[j] = __builtin_amdgcn_rcpf(1.f + ex2(-LOG2E * v0[j])); v1[j] = __builtin_amdgcn_rcpf(1.f + ex2(-LOG2E * v1[j])); } }
                    *(h8*)(rowp + bj * HALF) = pack8(v0[0], v0[1], v0[2], v0[3], v1[0], v1[1], v1[2], v1[3]); } }
    }
};
struct EpiSwiGLU {
    half_t* O; int ldc;
    __device__ __forceinline__ void operator()(const Acc& acc, const Unit& u, int wr, int wc, int fr, int fq) const {
        const int row0 = u.pm * BM + wr * 64 + fr, col0 = u.pn * HALF + wc * 32 + 8 * fq;
#pragma unroll
        for (int ai = 0; ai < 2; ++ai)
#pragma unroll
            for (int m = 0; m < 4; ++m) { half_t* rowp = O + (size_t)(row0 + ai * HALF + m * 16) * ldc + col0; float o[8];
#pragma unroll
                for (int n = 0; n < 2; ++n)
#pragma unroll
                    for (int j = 0; j < 4; ++j) { const float a = acc[ai][0][m][n][j], b = acc[ai][1][m][n][j]; o[4 * n + j] = a * __builtin_amdgcn_rcpf(1.f + ex2(-LOG2E * a)) * b; }
                *(h8*)rowp = pack8(o[0], o[1], o[2], o[3], o[4], o[5], o[6], o[7]); }
    }
};
struct EpiRes {
    const half_t* X; float* V; float s;
    __device__ __forceinline__ void operator()(const Acc& acc, const Unit& u, int wr, int wc, int fr, int fq) const {
        const int row0 = u.pm * BM + wr * 64 + fr, col0 = u.pn * BM + wc * 32 + 8 * fq;
#pragma unroll
        for (int ai = 0; ai < 2; ++ai)
#pragma unroll
            for (int m = 0; m < 4; ++m) { const size_t off = (size_t)(row0 + ai * HALF + m * 16) * D + col0;
#pragma unroll
                for (int bj = 0; bj < 2; ++bj) { const h8 xv = *(const h8*)(X + off + bj * HALF); f32x4 o0, o1;
#pragma unroll
                    for (int j = 0; j < 4; ++j) { o0[j] = ALPHA * (float)xv[j] + s * acc[ai][bj][m][0][j]; o1[j] = ALPHA * (float)xv[4 + j] + s * acc[ai][bj][m][1][j]; }
                    *(f32x4*)(V + off + bj * HALF) = o0; *(f32x4*)(V + off + bj * HALF + 4) = o1; } }
    }
};
template <bool FIRST> struct EpiGate {
    const half_t* G; int ldg; half_t* MG;
    __device__ __forceinline__ void operator()(const Acc& acc, const Unit& u, int wr, int wc, int fr, int fq) const {
        const int row0 = u.pm * BM + wr * 64 + fr, col0 = u.pn * BM + wc * 32 + 8 * fq;
#pragma unroll
        for (int ai = 0; ai < 2; ++ai)
#pragma unroll
            for (int m = 0; m < 4; ++m) { const int row = row0 + ai * HALF + m * 16;
#pragma unroll
                for (int bj = 0; bj < 2; ++bj) { const h8 gv = *(const h8*)(G + (size_t)row * ldg + col0 + bj * HALF); half_t* mp = MG + (size_t)row * D + col0 + bj * HALF; float o[8];
#pragma unroll
                    for (int j = 0; j < 4; ++j) { o[j] = (float)gv[j] * acc[ai][bj][m][0][j]; o[4 + j] = (float)gv[4 + j] * acc[ai][bj][m][1][j]; }
                    if (!FIRST) { const h8 pv = *(const h8*)mp;
#pragma unroll
                        for (int j = 0; j < 8; ++j) o[j] += (float)pv[j]; }
                    *(h8*)mp = pack8(o[0], o[1], o[2], o[3], o[4], o[5], o[6], o[7]); } }
    }
};

template <class Epi, class Sched>
__device__ __forceinline__ void gemm_phase(LAS unsigned char* lds, const Gemm g, const Sched& Sd, const Epi& E) {
    const int tid = opaque_tid(), wid = __builtin_amdgcn_readfirstlane(tid >> 6), lane = tid & 63, wr = wid >> 2, wc = wid & 3, fr = lane & 15, fq = lane >> 4;
    const int K = g.K, nt = K / BK;
    unsigned voffA[2], voffB[2];
#pragma unroll
    for (int i = 0; i < 2; ++i) { int R, C; stage_rc(tid * 16 + i * 8192, R, C); const int Rb = (R & ~31) + perm32(R & 31);
        voffA[i] = (unsigned)(R * K + C) * 2u; voffB[i] = (unsigned)(Rb * K + C) * 2u; }
    const size_t kstep = (size_t)(BK * 2);
    const size_t hstep = (size_t)HALF * K * 2;
    const size_t tstep = 2 * hstep;
    const unsigned ldsw = (unsigned)wid * 1024u;
    const int aoff = lds_byte(wr * 64 + fr, fq * 8), boff = lds_byte(wc * 32 + fr, fq * 8);
#define PG8_SA(b, h) (((b) * 2 + (h)) * HTB)
#define PG8_SB(b, h) ((4 + (b) * 2 + (h)) * HTB)
#define PG8_STAGE(bufoff, gbase, voff) do { _Pragma("unroll") for (int _i = 0; _i < 2; ++_i) \
        __builtin_amdgcn_global_load_lds((const unsigned*)((const char*)(gbase) + (voff)[_i]), (LAS unsigned*)(lds + (bufoff) + ldsw + _i * 8192), 16, 0, 0); } while (0)
#define PG8_LDA(dst, b, h) do { _Pragma("unroll") for (int m = 0; m < 4; ++m) _Pragma("unroll") for (int k = 0; k < 2; ++k) dst[m][k] = *(const LAS h8*)(lds + PG8_SA(b, h) + aoff + m * 2048 + k * 1024); } while (0)
#define PG8_LDB(dst, b, h) do { _Pragma("unroll") for (int n = 0; n < 2; ++n) _Pragma("unroll") for (int k = 0; k < 2; ++k) dst[n][k] = *(const LAS h8*)(lds + PG8_SB(b, h) + boff + n * 2048 + k * 1024); } while (0)
#define PG8_MMA(ai, bj, At, Bt) do { __builtin_amdgcn_s_setprio(1); _Pragma("unroll") for (int m = 0; m < 4; ++m) _Pragma("unroll") for (int n = 0; n < 2; ++n) _Pragma("unroll") for (int k = 0; k < 2; ++k) \
        acc[ai][bj][m][n] = __builtin_amdgcn_mfma_f32_16x16x32_f16(Bt[n][k], At[m][k], acc[ai][bj][m][n], 0, 0, 0); __builtin_amdgcn_s_setprio(0); } while (0)
#define PG8_WAIT_V(n) asm volatile("s_waitcnt vmcnt(" #n ")" ::: "memory")
#define PG8_WAIT_L(n) asm volatile("s_waitcnt lgkmcnt(" #n ")" ::: "memory")
#define PG8_BAR __builtin_amdgcn_s_barrier()
#define PG8_SCHED __builtin_amdgcn_sched_barrier(0)
    Unit cur, nxt; int ui = 0;
    if (!Sd.next(0, cur)) return;
    Acc acc;
#pragma unroll
    for (int a = 0; a < 2; ++a)
#pragma unroll
        for (int b = 0; b < 2; ++b)
#pragma unroll
            for (int m = 0; m < 4; ++m)
#pragma unroll
                for (int n = 0; n < 2; ++n) acc[a][b][m][n] = (f32x4){0.f, 0.f, 0.f, 0.f};
    h8 At[4][2], B0[2][2], B1[2][2];
    const char* cA = (const char*)g.A + (size_t)cur.pm * tstep; const char* cB = (const char*)g.Bt + (size_t)cur.pn * tstep;
    Sd.a_ready(cur);
    PG8_STAGE(PG8_SB(0, 0), cB, voffB); PG8_STAGE(PG8_SA(0, 0), cA, voffA); PG8_STAGE(PG8_SB(0, 1), cB + hstep, voffB); PG8_STAGE(PG8_SA(0, 1), cA + hstep, voffA);
    if (wr == 1) PG8_BAR;
    PG8_WAIT_V(4); PG8_BAR;
    PG8_STAGE(PG8_SB(1, 0), cB + kstep, voffB); PG8_STAGE(PG8_SA(1, 0), cA + kstep, voffA); PG8_STAGE(PG8_SB(1, 1), cB + hstep + kstep, voffB);
    PG8_WAIT_V(6); PG8_BAR;
    for (;;) {
        const bool has_next = Sd.next(ui + 1, nxt);
        const char* nA = has_next ? (const char*)g.A + (size_t)nxt.pm * tstep : cA; const char* nB = has_next ? (const char*)g.Bt + (size_t)nxt.pn * tstep : cB;
        for (int t = 0; t < nt; t += 2) {
            const bool last = (t == nt - 2);
            const char* a1 = cA + (size_t)(t + 1) * kstep;
            const char* a2 = last ? nA : cA + (size_t)(t + 2) * kstep; const char* b2 = last ? nB : cB + (size_t)(t + 2) * kstep;
            const char* a3 = a2 + kstep; const char* b3 = b2 + kstep;
            if (last && has_next) Sd.a_ready(nxt);
            PG8_LDB(B0, 0, 0); PG8_SCHED; PG8_LDA(At, 0, 0); PG8_STAGE(PG8_SA(1, 1), a1 + hstep, voffA);
            PG8_WAIT_L(8); PG8_BAR; PG8_WAIT_L(0); PG8_MMA(0, 0, At, B0); PG8_BAR; PG8_SCHED;
            PG8_LDB(B1, 0, 1); PG8_STAGE(PG8_SB(0, 0), b2, voffB);
            PG8_BAR; PG8_WAIT_L(0); PG8_MMA(0, 1, At, B1); PG8_BAR;
            PG8_LDA(At, 0, 1); PG8_STAGE(PG8_SA(0, 0), a2, voffA);
            PG8_BAR; PG8_WAIT_L(0); PG8_MMA(1, 0, At, B0); PG8_BAR; PG8_SCHED;
            PG8_STAGE(PG8_SB(0, 1), b2 + hstep, voffB);
            PG8_WAIT_V(6); PG8_BAR; PG8_MMA(1, 1, At, B1); PG8_BAR;
            PG8_LDB(B0, 1, 0); PG8_SCHED; PG8_LDA(At, 1, 0); PG8_STAGE(PG8_SA(0, 1), a2 + hstep, voffA);
            PG8_WAIT_L(8); PG8_BAR; PG8_WAIT_L(0); PG8_MMA(0, 0, At, B0); PG8_BAR; PG8_SCHED;
            PG8_LDB(B1, 1, 1); PG8_STAGE(PG8_SB(1, 0), b3, voffB);
            PG8_BAR; PG8_WAIT_L(0); PG8_MMA(0, 1, At, B1); PG8_BAR;
            PG8_LDA(At, 1, 1); PG8_STAGE(PG8_SA(1, 0), a3, voffA);
            PG8_BAR; PG8_WAIT_L(0); PG8_MMA(1, 0, At, B0); PG8_BAR; PG8_SCHED;
            PG8_STAGE(PG8_SB(1, 1), b3 + hstep, voffB);
            PG8_WAIT_V(6); PG8_BAR; PG8_MMA(1, 1, At, B1); PG8_BAR;
        }
        E(acc, cur, wr, wc, fr, fq); Sd.done(cur);
        if (!has_next) break;
#pragma unroll
        for (int a = 0; a < 2; ++a)
#pragma unroll
            for (int b = 0; b < 2; ++b)
#pragma unroll
                for (int m = 0; m < 4; ++m)
#pragma unroll
                    for (int n = 0; n < 2; ++n) acc[a][b][m][n] = (f32x4){0.f, 0.f, 0.f, 0.f};
        cur = nxt; cA = nA; cB = nB; ++ui;
    }
    PG8_WAIT_V(0);
    if (wr == 0) PG8_BAR;
    PG8_BAR;
#undef PG8_SA
#undef PG8_SB
#undef PG8_STAGE
#undef PG8_LDA
#undef PG8_LDB
#undef PG8_MMA
#undef PG8_WAIT_V
#undef PG8_WAIT_L
#undef PG8_BAR
#undef PG8_SCHED
}
}
#define XB_TMO      128
#define XB_XCNT(j)  (256  + 64 * (j))
#define XB_XSUB(j)  (1280 + 64 * (j))
#define XB_XGEN(j)  (2304 + 64 * (j))
#define XB_TOP      3328
#define XB_TOPGEN   3392
#define XCD_BAR_WORDS 3456
#define XB_SPIN_CAP (1u << 18)
__device__ __forceinline__ unsigned xb_ld(unsigned* p)              { return __hip_atomic_load(p, __ATOMIC_RELAXED, __HIP_MEMORY_SCOPE_AGENT); }
__device__ __forceinline__ unsigned xb_add(unsigned* p, unsigned v) { return __hip_atomic_fetch_add(p, v, __ATOMIC_RELAXED, __HIP_MEMORY_SCOPE_AGENT); }
__device__ __forceinline__ unsigned xb_xcc_id() { return (unsigned)__builtin_amdgcn_s_getreg((3 << 11) | 20) & 0xFu; }
#define XB_SPIN(cond, bar) do { unsigned _sp = 0; while (cond) { __builtin_amdgcn_s_sleep(1); \
    if ((++_sp & 255u) == 0u) { if (xb_ld(&(bar)[XB_TMO])) break; if (_sp > XB_SPIN_CAP) { atomicAdd(&(bar)[XB_TMO], 1u); break; } } } } while (0)
struct XcdBarrier { unsigned* bar; unsigned x; volatile LAS unsigned* st; };
__device__ __forceinline__ XcdBarrier xcd_barrier_post(unsigned* bar, volatile LAS unsigned* st) {
    XcdBarrier b; b.bar = bar; b.x = xb_xcc_id(); b.st = st;
    if (threadIdx.x == 0) (void)xb_add(&bar[XB_XCNT(b.x)], 1u);
    return b;
}
__device__ __forceinline__ void xcd_barrier_complete(unsigned* bar, unsigned x, unsigned& nloc, unsigned& nx) {
    const unsigned G = gridDim.x * gridDim.y * gridDim.z;
    unsigned sum, cnt, mine, sp = 0u;
    for (;;) {
        sum = 0u; cnt = 0u; mine = 0u;
#pragma unroll
        for (unsigned j = 0; j < 16; ++j) { const unsigned c = xb_ld(&bar[XB_XCNT(j)]); sum += c; cnt += (c > 0u) ? 1u : 0u; mine = (j == x) ? c : mine; }
        if (sum == G) break;
        __builtin_amdgcn_s_sleep(1);
        if ((++sp & 255u) == 0u) { if (xb_ld(&bar[XB_TMO])) break; if (sp > XB_SPIN_CAP) { atomicAdd(&bar[XB_TMO], 1u); break; } }
    }
    nloc = mine > 0u ? mine : 1u; nx = cnt > 0u ? cnt : 1u;
}
__device__ __forceinline__ void xcd_barrier(const XcdBarrier& b) {
    asm volatile("s_waitcnt vmcnt(0)" ::: "memory");
    __syncthreads();
    if (threadIdx.x == 0) {
        unsigned* bar = b.bar;
        __builtin_amdgcn_s_waitcnt(0);
        unsigned nloc = b.st[0], nx = b.st[1];
        if (nloc == 0u) { xcd_barrier_complete(bar, b.x, nloc, nx); b.st[0] = nloc; b.st[1] = nx; }
        const unsigned old = xb_add(&bar[XB_XSUB(b.x)], 1u);
        const unsigned gen = old / nloc;
        if (old + 1u == (gen + 1u) * nloc) {
            __builtin_amdgcn_fence(__ATOMIC_RELEASE, "agent");
            asm volatile("s_waitcnt vmcnt(0)" ::: "memory");
            const unsigned og = xb_add(&bar[XB_TOP], 1u);
            const unsigned tg = og / nx;
            if (og + 1u == (tg + 1u) * nx) xb_add(&bar[XB_TOPGEN], 1u);
            else XB_SPIN(xb_ld(&bar[XB_TOPGEN]) == tg, bar);
            __builtin_amdgcn_fence(__ATOMIC_ACQUIRE, "agent");
            xb_add(&bar[XB_XGEN(b.x)], 1u);
            asm volatile("s_waitcnt vmcnt(0)" ::: "memory");
        } else {
            XB_SPIN(xb_ld(&bar[XB_XGEN(b.x)]) == gen, bar);
            __builtin_amdgcn_fence(__ATOMIC_ACQUIRE, "agent");
            asm volatile("s_waitcnt vmcnt(0)" ::: "memory");
        }
    }
    __syncthreads();
}

struct Frame {
    LAS unsigned char* lds;
    int tid, lane, wave, vcu, G;
    const float *x_in, *mem, *ln_g, *ln_b, *ffn_w_in, *ffn_w_out, *w_mix_in, *b_gate, *kv_g, *w_uk, *w_uv, *conv_w, *w_branch, *w_mix_out, *xa_wq, *xa_wkv, *xa_wo, *rel_bias;
    unsigned char* ws; unsigned char* dout;
};
__device__ __forceinline__ float wave_sum(float v) {
#pragma unroll
    for (int o = 1; o < 64; o <<= 1) v += __shfl_xor(v, o);
    return v;
}

__device__ __forceinline__ void tr_item(const float* W, int ldw, int c0, half_t* dst, int K, int r0, int k0, float scale, LAS float* scr, int lane) {
#pragma unroll 8
    for (int i = 0; i < 32; ++i) { const int kk = 2 * i + (lane >> 5); scr[kk * 33 + (lane & 31)] = W[(size_t)(k0 + kk) * ldw + c0 + (lane & 31)]; }
    LDS_WAIT(); CFENCE();
    const int c = lane & 7;
#pragma unroll
    for (int j = 0; j < 4; ++j) { const int n = (lane >> 3) + 8 * j; const LAS float* s = scr + (8 * c) * 33 + n;
        *(h8*)(dst + (size_t)(r0 + n) * K + k0 + 8 * c) = pack8(s[0] * scale, s[33] * scale, s[66] * scale, s[99] * scale, s[132] * scale, s[165] * scale, s[198] * scale, s[231] * scale); }
    LDS_WAIT(); CFENCE();
}
__device__ __forceinline__ void mix_src(int nb, int& c0, float& scale) {
    const int r = nb * 32; scale = 1.f;
    if (r < C_QS) { c0 = O_IQ + (r - C_IQ); }
    else if (r < C_KS) { c0 = O_QS + (r - C_QS); scale = 0.125f * LOG2E; }
    else if (r < C_VS) { c0 = O_KS + (r - C_KS); }
    else if (r < C_CB) { c0 = O_VS + (r - C_VS); }
    else if (r < C_CC) { c0 = O_CB + (r - C_CB); }
    else if (r < C_CH) { c0 = O_CC + (r - C_CC); }
    else if (r < C_G) { c0 = O_CH + (r - C_CH); }
    else if (r < C_CKV) { c0 = O_GA + (r - C_G); }
    else if (r < C_IK) { c0 = O_CKV + (r - C_CKV); }
    else { c0 = O_IK + (r - C_IK); }
}
__device__ __forceinline__ void p_prep(Frame& F, int l) {
    LAS float* scr = (LAS float*)(F.lds + F.wave * 16384);
    const int gw = F.vcu * NWAVES + F.wave, NGW = F.G * NWAVES, lane = F.lane;
    half_t* WFIN = (half_t*)(F.ws + WS_WFIN); half_t* WFOUT = (half_t*)(F.ws + WS_WFOUT); half_t* WMIX = (half_t*)(F.ws + WS_WMIX);
    half_t* WBRA = (half_t*)(F.ws + WS_WBRA); half_t* WBRB = (half_t*)(F.ws + WS_WBRB); half_t* WBRC = (half_t*)(F.ws + WS_WBRC);
    half_t* WMO = (half_t*)(F.ws + WS_WMO); half_t* WXQ = (half_t*)(F.ws + WS_WXQ); half_t* WXKV = (half_t*)(F.ws + WS_WXKV); half_t* WXO = (half_t*)(F.ws + WS_WXO);
    const float* w_in_l = F.w_mix_in + (size_t)l * D * PT;
    constexpr int I_FIN = 176 * 16, I_FOUT = 32 * 44, I_MIX = 214 * 16, I_BR = 32 * 8, I_MO = 32 * 16, I_XQ = 16 * 16, I_XKV = 32 * 16, I_XO = 32 * 8;
    constexpr int NITEMS = 2 * I_FIN + 2 * I_FOUT + I_MIX + 2 * I_BR + I_MO + I_XQ + I_XKV + I_XO;
    for (int it = gw; it < NITEMS; it += NGW) {
        int r = it;
        if (r < 2 * I_FIN) { const int which = r / I_FIN; r -= which * I_FIN; const int nb = r / 16, kb = r % 16, pn = nb >> 3, w8 = nb & 7;
            const int c0 = (w8 < 4) ? (128 * pn + 32 * w8) : (DFF + 128 * pn + 32 * (w8 - 4));
            tr_item(F.ffn_w_in + (size_t)(l * 2 + which) * D * 2 * DFF, 2 * DFF, c0, WFIN + (size_t)which * 5632 * 1024, 1024, nb * 32, kb * 64, 1.f, scr, lane); continue; }
        r -= 2 * I_FIN;
        if (r < 2 * I_FOUT) { const int which = r / I_FOUT; r -= which * I_FOUT; const int nb = r / 44, kb = r % 44;
            tr_item(F.ffn_w_out + (size_t)(l * 2 + which) * DFF * D, D, nb * 32, WFOUT + (size_t)which * 1024 * DFF, DFF, nb * 32, kb * 64, 1.f, scr, lane); continue; }
        r -= 2 * I_FOUT;
        if (r < I_MIX) { const int nb = 32 + r / 16, kb = r % 16; int c0; float sc; mix_src(nb, c0, sc);
            tr_item(w_in_l, PT, c0, WMIX, 1024, nb * 32, kb * 64, sc, scr, lane); continue; }
        r -= I_MIX;
        if (r < 2 * I_BR) { const int which = r / I_BR; r -= which * I_BR; const int nb = r / 8, kb = r % 8;
            tr_item(F.w_branch + (size_t)(l * 3 + 1 + which) * 512 * D, D, nb * 32, which ? WBRC : WBRB, 512, nb * 32, kb * 64, 1.f, scr, lane); continue; }
        r -= 2 * I_BR;
        if (r < I_MO) { const int nb = r / 16, kb = r % 16; tr_item(F.w_mix_out + (size_t)l * D * D, D, nb * 32, WMO, 1024, nb * 32, kb * 64, 1.f, scr, lane); continue; }
        r -= I_MO;
        if (r < I_XQ) { const int nb = r / 16, kb = r % 16; tr_item(F.xa_wq + (size_t)l * D * 512, 512, nb * 32, WXQ, 1024, nb * 32, kb * 64, 0.08838834764831845f * LOG2E, scr, lane); continue; }
        r -= I_XQ;
        if (r < I_XKV) { const int nb = r / 16, kb = r % 16; tr_item(F.xa_wkv + (size_t)l * D * 1024, 1024, nb * 32, WXKV, 1024, nb * 32, kb * 64, 1.f, scr, lane); continue; }
        r -= I_XKV;
        { const int nb = r / 8, kb = r % 8; tr_item(F.xa_wo + (size_t)l * 512 * D, D, nb * 32, WXO, 512, nb * 32, kb * 64, 1.f, scr, lane); }
    }
    for (int tk = gw; tk < 8 * 2 * 32; tk += NGW) {
        const int h = tk >> 6, chalf = (tk >> 5) & 1, kb = tk & 31, c = chalf * 64 + lane;
        float wk[64];
#pragma unroll
        for (int d = 0; d < 64; ++d) wk[d] = F.w_uk[((size_t)(l * 8 + h) * 64 + d) * 128 + c] * (0.125f * LOG2E);
#pragma unroll 1
        for (int kk = 0; kk < 32; ++kk) { const float* wr_ = w_in_l + (size_t)(kb * 32 + kk) * PT + O_QA + h * 64; float a0 = 0.f, a1 = 0.f;
#pragma unroll
            for (int d = 0; d < 64; d += 2) { a0 += wr_[d] * wk[d]; a1 += wr_[d + 1] * wk[d + 1]; }
            WMIX[(size_t)(h * 128 + c) * 1024 + kb * 32 + kk] = (half_t)(a0 + a1); }
    }
    for (int tk = gw; tk < 8 * 16 * 4; tk += NGW) {
        const int h = tk >> 6, nblk = (tk >> 2) & 15, cq = tk & 3, n = nblk * 64 + lane;
        const float* wb0 = F.w_branch + (size_t)(l * 3) * 512 * D;
        float wb[64];
#pragma unroll
        for (int d = 0; d < 64; ++d) wb[d] = wb0[(size_t)(h * 64 + d) * D + n];
#pragma unroll 1
        for (int cc = 0; cc < 32; ++cc) { const float* uv = F.w_uv + ((size_t)(l * 8 + h) * 128 + cq * 32 + cc) * 64; float a0 = 0.f, a1 = 0.f;
#pragma unroll
            for (int d = 0; d < 64; d += 2) { a0 += uv[d] * wb[d]; a1 += uv[d + 1] * wb[d + 1]; }
            WBRA[(size_t)n * 1024 + h * 128 + cq * 32 + cc] = (half_t)(a0 + a1); }
    }
    for (int i = gw * 64 + lane; i < 64 * 1024; i += NGW * 64) { const int rr = i >> 10, k = i & 1023;
        WMIX[(size_t)(C_IW + rr) * 1024 + k] = rr < 8 ? (half_t)(w_in_l[(size_t)k * PT + O_IW + rr] * (0.35355339059327373f * 0.125f)) : (half_t)0.f; }
    { float* bias = (float*)(F.ws + WS_BIAS);
      for (int i = gw * 64 + lane; i < NMIX; i += NGW * 64) bias[i] = (i >= C_G && i < C_CKV) ? F.b_gate[(size_t)l * 3 * D + (i - C_G)] : 0.f; }
    { half_t* MEMH = (half_t*)(F.ws + WS_MEMH); half_t* MEMP = (half_t*)(F.ws + WS_MEMP);
      for (int i = gw * 64 + lane; i < 2048 * 128; i += NGW * 64) { const int row = i >> 7, c8 = (i & 127) * 8;
          const f32x4 a = *(const f32x4*)(F.mem + (size_t)row * 1024 + c8), b = *(const f32x4*)(F.mem + (size_t)row * 1024 + c8 + 4);
          const h8 v = pack8(a[0], a[1], a[2], a[3], b[0], b[1], b[2], b[3]);
          *(h8*)(MEMH + (size_t)row * 1024 + c8) = v;
          const int prow = (row & ~12) | ((row & 4) << 1) | ((row & 8) >> 1);
          *(h8*)(MEMP + (size_t)prow * 1024 + c8) = v; } }
}
__device__ __forceinline__ void p_x_to_half(Frame& F) {
    half_t* X = (half_t*)(F.ws + WS_X); const int gt = (F.vcu * NWAVES + F.wave) * 64 + F.lane, NT = F.G * NWAVES * 64;
    for (size_t i = gt; i < (size_t)M * D / 8; i += NT) { const f32x4 a = *(const f32x4*)(F.x_in + i * 8), b = *(const f32x4*)(F.x_in + i * 8 + 4);
        *(h8*)(X + i * 8) = pack8(a[0], a[1], a[2], a[3], b[0], b[1], b[2], b[3]); }
}
__device__ __forceinline__ void p_ln(Frame& F, const float* V, const float* g, const float* b, float* outf) {
    half_t* X = (half_t*)(F.ws + WS_X); const int gw = F.vcu * NWAVES + F.wave, NGW = F.G * NWAVES, lane = F.lane;
    f32x4 gv[4], bv[4];
#pragma unroll
    for (int j = 0; j < 4; ++j) { gv[j] = *(const f32x4*)(g + 256 * j + 4 * lane); bv[j] = *(const f32x4*)(b + 256 * j + 4 * lane); }
    for (int m = gw; m < M; m += NGW) {
        const float* vr = V + (size_t)m * D; f32x4 v[4]; float s = 0.f;
#pragma unroll
        for (int j = 0; j < 4; ++j) { v[j] = *(const f32x4*)(vr + 256 * j + 4 * lane); s += (v[j][0] + v[j][1]) + (v[j][2] + v[j][3]); }
        const float mean = wave_sum(s) * (1.f / D); float s2 = 0.f;
#pragma unroll
        for (int j = 0; j < 4; ++j) { v[j] = v[j] - mean; s2 += (v[j][0] * v[j][0] + v[j][1] * v[j][1]) + (v[j][2] * v[j][2] + v[j][3] * v[j][3]); }
        const float rstd = 1.f / sqrtf(wave_sum(s2) * (1.f / D) + LN_EPS);
#pragma unroll
        for (int j = 0; j < 4; ++j) { const f32x4 o = v[j] * rstd * gv[j] + bv[j];
            *(h4*)(X + (size_t)m * D + 256 * j + 4 * lane) = pack4(o[0], o[1], o[2], o[3]);
            if (outf) *(f32x4*)(outf + (size_t)m * D + 256 * j + 4 * lane) = o; }
    }
}
__device__ __forceinline__ h8 tr_pair(const LAS unsigned char* p0, const LAS unsigned char* p1) {
    const s4v a = __builtin_amdgcn_ds_read_tr16_b64_v4i16((LAS s4v*)p0);
    const s4v b = __builtin_amdgcn_ds_read_tr16_b64_v4i16((LAS s4v*)p1);
    const s8v r = __builtin_shufflevector(a, b, 0, 1, 2, 3, 4, 5, 6, 7);
    return __builtin_bit_cast(h8, r);
}
__device__ __forceinline__ int crow(int i, int h) { return (i & 3) + 8 * (i >> 2) + 4 * h; }

constexpr int SB_VPITCH = 144;
__device__ __forceinline__ void sb_job(Frame& F, const half_t* MIX, half_t* YB, int job) {
    const int lane = F.lane, r = lane & 31, hh = lane >> 5;
    const int blk = job & 127, h = (job >> 7) & 7, b = job >> 10;
    const size_t R0 = (size_t)b * S; const int t0 = blk * 32;
    LAS unsigned char* vb = F.lds + F.wave * 8192;
    h8 qf[4];
#pragma unroll
    for (int st = 0; st < 4; ++st) qf[st] = *(const h8*)(MIX + (R0 + t0 + r) * NMIX + C_QS + h * 64 + 16 * st + 8 * hh);
    f32x16 oacc[2];
#pragma unroll
    for (int c = 0; c < 2; ++c)
#pragma unroll
        for (int i = 0; i < 16; ++i) oacc[c][i] = 0.f;
    float Rsum = 0.f;
    for (int kt = blk; kt >= 0; --kt) {
        const size_t kr = R0 + (size_t)kt * 32;
        h8 kf[4], vv[4];
#pragma unroll
        for (int st = 0; st < 4; ++st) kf[st] = *(const h8*)(MIX + (kr + r) * NMIX + C_KS + h * 64 + 16 * st + 8 * hh);
#pragma unroll
        for (int i = 0; i < 4; ++i) vv[i] = *(const h8*)(MIX + (kr + 8 * i + (lane >> 3)) * NMIX + C_VS + h * 64 + 8 * (lane & 7));
        f32x16 sacc;
#pragma unroll
        for (int i = 0; i < 16; ++i) sacc[i] = 0.f;
#pragma unroll
        for (int st = 0; st < 4; ++st) sacc = __builtin_amdgcn_mfma_f32_32x32x16_f16(kf[st], qf[st], sacc, 0, 0, 0);
        CFENCE();
#pragma unroll
        for (int i = 0; i < 4; ++i) *(LAS h8*)(vb + (8 * i + (lane >> 3)) * SB_VPITCH + 16 * (lane & 7)) = vv[i];
        CFENCE();
        const bool diag = (kt == blk);
        float L[16], zl[16];
#pragma unroll
        for (int i = 0; i < 16; ++i) {
            const float z = sacc[i]; const float sp = fmaxf(z, 0.f) + lg2(1.f + ex2(-fabsf(z)));
            const bool ok = !diag || (crow(i, hh) < r);
            L[i] = ok ? -sp : 0.f; zl[i] = ok ? (z - sp) : -1e30f;
        }
        float bs[4], pbs[4];
#pragma unroll
        for (int q = 0; q < 4; ++q) { bs[q] = (L[4 * q] + L[4 * q + 1]) + (L[4 * q + 2] + L[4 * q + 3]); pbs[q] = __shfl_xor(bs[q], 32); }
        float after[4]; after[3] = 0.f; after[2] = bs[3] + pbs[3]; after[1] = after[2] + (bs[2] + pbs[2]); after[0] = after[1] + (bs[1] + pbs[1]);
        const float tile_total = after[0] + (bs[0] + pbs[0]);
        float p[16];
#pragma unroll
        for (int q = 0; q < 4; ++q) {
            const float base = Rsum + after[q] + (hh == 0 ? pbs[q] : 0.f);
            const float s3 = base, s2 = s3 + L[4 * q + 3], s1 = s2 + L[4 * q + 2], s0 = s1 + L[4 * q + 1];
            p[4 * q + 3] = ex2(zl[4 * q + 3] + s3); p[4 * q + 2] = ex2(zl[4 * q + 2] + s2); p[4 * q + 1] = ex2(zl[4 * q + 1] + s1); p[4 * q] = ex2(zl[4 * q] + s0);
        }
        Rsum += tile_total;
        const h8 pf0 = pack8(p[0], p[1], p[2], p[3], p[4], p[5], p[6], p[7]), pf1 = pack8(p[8], p[9], p[10], p[11], p[12], p[13], p[14], p[15]);
        const int q4 = (lane & 15) >> 2, pp = lane & 3, blk16 = (lane >> 4) & 1;
#pragma unroll
        for (int c = 0; c < 2; ++c)
#pragma unroll
            for (int s2 = 0; s2 < 2; ++s2) {
                const LAS unsigned char* a0 = vb + (16 * s2 + 4 * hh + q4) * SB_VPITCH + (32 * c + 16 * blk16) * 2 + 8 * pp;
                const h8 vf = tr_pair(a0, a0 + 8 * SB_VPITCH);
                oacc[c] = __builtin_amdgcn_mfma_f32_32x32x16_f16(vf, s2 ? pf1 : pf0, oacc[c], 0, 0, 0);
            }
        CFENCE();
        if (__ballot(Rsum > -160.f) == 0ull) break;
    }
    half_t* orow = YB + (R0 + t0 + r) * 512 + h * 64;
#pragma unroll
    for (int c = 0; c < 2; ++c)
#pragma unroll
        for (int q = 0; q < 4; ++q) *(h4*)(orow + 32 * c + 8 * q + 4 * hh) = pack4(oacc[c][4 * q], oacc[c][4 * q + 1], oacc[c][4 * q + 2], oacc[c][4 * q + 3]);
}

__device__ __forceinline__ void rms_job(Frame& F, const half_t* MIX, half_t* CKVN, const float* kvg, int job) {
    const int lane = F.lane, row = job * 4 + (lane >> 4), c8 = (lane & 15) * 8;
    const h8 v = *(const h8*)(MIX + (size_t)row * NMIX + C_CKV + c8); float f[8], s = 0.f;
#pragma unroll
    for (int j = 0; j < 8; ++j) { f[j] = (float)v[j]; s += f[j] * f[j]; }
    s += __shfl_xor(s, 1); s += __shfl_xor(s, 2); s += __shfl_xor(s, 4); s += __shfl_xor(s, 8);
    const float rs = 1.f / sqrtf(s * (1.f / 128.f) + LN_EPS);
    const f32x4 g0 = *(const f32x4*)(kvg + c8), g1 = *(const f32x4*)(kvg + c8 + 4);
    *(h8*)(CKVN + (size_t)row * 128 + c8) = pack8(f[0] * rs * g0[0], f[1] * rs * g0[1], f[2] * rs * g0[2], f[3] * rs * g0[3], f[4] * rs * g1[0], f[5] * rs * g1[1], f[6] * rs * g1[2], f[7] * rs * g1[3]);
}
__device__ __forceinline__ void conv_job(Frame& F, const half_t* MIX, half_t* YC, const float* cw, int job) {
    const int lane = F.lane, c8 = lane * 8, row0 = job * 64, tb = row0 & (S - 1);
    float w0[8], w1[8], w2[8], z1[8], z2[8];
#pragma unroll
    for (int j = 0; j < 8; ++j) { w0[j] = cw[c8 + j]; w1[j] = cw[512 + c8 + j]; w2[j] = cw[1024 + c8 + j]; z1[j] = 0.f; z2[j] = 0.f; }
    if (tb != 0) {
        const h8 a1 = *(const h8*)(MIX + (size_t)(row0 - 1) * NMIX + C_CC + c8), b1 = *(const h8*)(MIX + (size_t)(row0 - 1) * NMIX + C_CH + c8);
        const h8 a2 = *(const h8*)(MIX + (size_t)(row0 - 2) * NMIX + C_CC + c8), b2 = *(const h8*)(MIX + (size_t)(row0 - 2) * NMIX + C_CH + c8);
#pragma unroll
        for (int j = 0; j < 8; ++j) { z1[j] = (float)a1[j] * (float)b1[j]; z2[j] = (float)a2[j] * (float)b2[j]; }
    }
    for (int i = 0; i < 64; ++i) {
        const size_t ro = (size_t)(row0 + i) * NMIX;
        const h8 cb = *(const h8*)(MIX + ro + C_CB + c8), cc = *(const h8*)(MIX + ro + C_CC + c8), chv = *(const h8*)(MIX + ro + C_CH + c8);
        float o[8];
#pragma unroll
        for (int j = 0; j < 8; ++j) { const float z0 = (float)cc[j] * (float)chv[j]; o[j] = (float)cb[j] * (w0[j] * z2[j] + w1[j] * z1[j] + w2[j] * z0); z2[j] = z1[j]; z1[j] = z0; }
        *(h8*)(YC + (size_t)(row0 + i) * 512 + c8) = pack8(o[0], o[1], o[2], o[3], o[4], o[5], o[6], o[7]);
    }
}

__device__ __forceinline__ unsigned f2ord(float f) { const unsigned u = __float_as_uint(f); return (u & 0x80000000u) ? ~u : (u | 0x80000000u); }
template <int NR>
__device__ __forceinline__ void topk_select(const float* sc, int t, LAS unsigned short* out, int lane) {
    unsigned u[NR];
#pragma unroll
    for (int j = 0; j < NR; ++j) { const int s = j * 64 + lane; const float f = sc[s]; u[j] = s <= t ? f2ord(f) : 0x007FFFFFu; }
    unsigned T = 0;
    for (int bit = 31; bit >= 0; --bit) {
        const unsigned cand = T | (1u << bit); int c = 0;
#pragma unroll
        for (int j = 0; j < NR; ++j) c += __builtin_popcountll(__ballot(u[j] >= cand));
        if (c >= 256) { T = cand; if (c == 256) break; }
    }
    int cgt = 0;
#pragma unroll
    for (int j = 0; j < NR; ++j) cgt += __builtin_popcountll(__ballot(u[j] > T));
    int need = 256 - cgt, base = 0;
    const unsigned long long below = (1ull << lane) - 1ull;
#pragma unroll
    for (int j = 0; j < NR; ++j) {
        const unsigned long long mgt = __ballot(u[j] > T), meq = __ballot(u[j] == T);
        const int eqrank = __builtin_popcountll(meq & below); const bool take_eq = (u[j] == T) && (eqrank < need);
        const unsigned long long msel = mgt | __ballot(take_eq);
        const int neq = __builtin_popcountll(meq); need -= neq < need ? neq : need;
        if ((msel >> lane) & 1ull) out[base + __builtin_popcountll(msel & below)] = (unsigned short)(j * 64 + lane);
        base += __builtin_popcountll(msel);
    }
}
__device__ __forceinline__ void idx_job(Frame& F, const half_t* MIX, unsigned short* IDX, float* SCR, int job) {
    const int lane = F.lane, wave = F.wave, r = lane & 31, hk = lane >> 5;
    const int b = job >> 8, qt = job & 255, t0 = qt * 16;
    const size_t R0 = (size_t)b * S;
    LAS float* wl = (LAS float*)(F.lds + 65536);
    LAS unsigned short* ol = (LAS unsigned short*)(F.lds + 66048 + wave * 512);
    float* sc = SCR + (size_t)blockIdx.x * (16 * 4096);
    if (t0 + 15 < 256) {
#pragma unroll
        for (int qq = 0; qq < 2; ++qq) { const int t = t0 + 2 * wave + qq; unsigned short k4[4];
#pragma unroll
            for (int j = 0; j < 4; ++j) { const int s = 4 * lane + j; k4[j] = s <= t ? (unsigned short)s : (unsigned short)0xFFFF; }
            *(u32x2*)(IDX + (R0 + t) * 256 + 4 * lane) = (u32x2){(unsigned)k4[0] | ((unsigned)k4[1] << 16), (unsigned)k4[2] | ((unsigned)k4[3] << 16)}; }
        return;
    }
    if (F.tid < 128) { const int q = F.tid >> 3, hd = F.tid & 7; wl[F.tid] = (float)MIX[(R0 + t0 + q) * NMIX + C_IW + hd]; }
    const int blk = r >> 2, e = r & 3, tq = 2 * (blk & 1) + (blk >> 2), hd = 4 * ((blk >> 1) & 1) + e;
    h8 af[4][4];
#pragma unroll
    for (int T = 0; T < 4; ++T)
#pragma unroll
        for (int st = 0; st < 4; ++st) af[T][st] = *(const h8*)(MIX + (R0 + t0 + 4 * T + tq) * NMIX + C_IQ + hd * 64 + 16 * st + 8 * hk);
    __syncthreads();
    const int nkt = (t0 + 16 + 31) >> 5;
    for (int kt = wave; kt < nkt; kt += NWAVES) {
        h8 bf[4];
#pragma unroll
        for (int st = 0; st < 4; ++st) bf[st] = *(const h8*)(MIX + (R0 + (size_t)kt * 32 + r) * NMIX + C_IK + 16 * st + 8 * hk);
#pragma unroll
        for (int T = 0; T < 4; ++T) {
            f32x16 acc;
#pragma unroll
            for (int i = 0; i < 16; ++i) acc[i] = 0.f;
#pragma unroll
            for (int st = 0; st < 4; ++st) acc = __builtin_amdgcn_mfma_f32_32x32x16_f16(af[T][st], bf[st], acc, 0, 0, 0);
#pragma unroll
            for (int q2 = 0; q2 < 2; ++q2) { const int ql = 4 * T + 2 * hk + q2;
                const f32x4 w0 = *(const LAS f32x4*)(wl + ql * 8), w1 = *(const LAS f32x4*)(wl + ql * 8 + 4); float sco = 0.f;
#pragma unroll
                for (int j = 0; j < 4; ++j) { sco += w0[j] * fmaxf(acc[q2 * 8 + j], 0.f); sco += w1[j] * fmaxf(acc[q2 * 8 + 4 + j], 0.f); }
                sc[ql * 4096 + kt * 32 + r] = sco; }
            __builtin_amdgcn_sched_barrier(0);
        }
    }
    VM_WAIT(); __syncthreads();
#pragma unroll 1
    for (int qq = 0; qq < 2; ++qq) {
        const int ql = 2 * wave + qq, t = t0 + ql; const float* srow = sc + ql * 4096;
        if (t0 + 16 <= 1024) topk_select<16>(srow, t, ol, lane);
        else if (t0 + 16 <= 2048) topk_select<32>(srow, t, ol, lane);
        else if (t0 + 16 <= 3072) topk_select<48>(srow, t, ol, lane);
        else topk_select<64>(srow, t, ol, lane);
        LDS_WAIT(); CFENCE();
        *(u32x2*)(IDX + (R0 + t) * 256 + 4 * lane) = *(const LAS u32x2*)(ol + 4 * lane);
        LDS_WAIT(); CFENCE();
    }
    VM_WAIT(); __syncthreads();
}
constexpr int GA_PITCH = 272;
constexpr int GA_WAVE_BYTES = 10240;
constexpr int GA_TAB_OFF = 8 * GA_WAVE_BYTES;
__device__ __forceinline__ void ga_tables(Frame& F) {
    LAS float* rb = (LAS float*)(F.lds + GA_TAB_OFF); LAS unsigned char* t5 = F.lds + GA_TAB_OFF + 1024;
    if (F.tid < 256) rb[F.tid] = F.rel_bias[F.tid] * LOG2E;
    if (F.tid < 128) t5[F.tid] = T5.v[F.tid];
    __syncthreads();
}
__device__ __forceinline__ void ga_job(Frame& F, const half_t* MIX, const half_t* CKVN, const unsigned short* IDX, half_t* YA, int row) {
    const int lane = F.lane, n16 = lane & 15, g = lane >> 4, t = row & (S - 1);
    const size_t R0 = (size_t)(row - t);
    LAS unsigned char* kvb = F.lds + F.wave * GA_WAVE_BYTES;
    LAS unsigned short* il = (LAS unsigned short*)(kvb + 8704);
    LAS float* al = (LAS float*)(kvb + 8704 + 512);
    const LAS float* rb = (const LAS float*)(F.lds + GA_TAB_OFF); const LAS unsigned char* t5 = F.lds + GA_TAB_OFF + 1024;
    *(LAS u32x2*)(il + 4 * lane) = *(const u32x2*)(IDX + (size_t)row * 256 + 4 * lane);
    h8 qf[4];
#pragma unroll
    for (int st = 0; st < 4; ++st) { h8 z;
#pragma unroll
        for (int j = 0; j < 8; ++j) z[j] = (half_t)0.f;
        qf[st] = n16 < 8 ? *(const h8*)(MIX + (size_t)row * NMIX + C_QL + n16 * 128 + 32 * st + 8 * g) : z; }
    f32x4 oacc[8];
#pragma unroll
    for (int nt = 0; nt < 8; ++nt) oacc[nt] = (f32x4){0.f, 0.f, 0.f, 0.f};
    float mrun = -1e30f, lsum = 0.f;
    LDS_WAIT(); CFENCE();
    h8 gr[8];
#pragma unroll
    for (int i = 0; i < 8; ++i) { unsigned key = il[4 * i + g]; key = key <= (unsigned)t ? key : 0u; gr[i] = *(const h8*)(CKVN + (R0 + key) * 128 + 8 * n16); }
#pragma unroll 1
    for (int ch = 0; ch < 8; ++ch) {
        CFENCE();
#pragma unroll
        for (int i = 0; i < 8; ++i) *(LAS h8*)(kvb + (4 * i + g) * GA_PITCH + 16 * n16) = gr[i];
        CFENCE();
        if (ch < 7) {
#pragma unroll
            for (int i = 0; i < 8; ++i) { unsigned key = il[32 * (ch + 1) + 4 * i + g]; key = key <= (unsigned)t ? key : 0u; gr[i] = *(const h8*)(CKVN + (R0 + key) * 128 + 8 * n16); }
        }
        f32x4 lacc[2];
#pragma unroll
        for (int u = 0; u < 2; ++u) { lacc[u] = (f32x4){0.f, 0.f, 0.f, 0.f};
#pragma unroll
            for (int st = 0; st < 4; ++st) { const h8 a = *(const LAS h8*)(kvb + (16 * u + n16) * GA_PITCH + (32 * st + 8 * g) * 2);
                lacc[u] = __builtin_amdgcn_mfma_f32_16x16x32_f16(a, qf[st], lacc[u], 0, 0, 0); } }
        float lg[8]; float cm = -1e30f;
#pragma unroll
        for (int u = 0; u < 2; ++u) { const u32x2 kk = *(const LAS u32x2*)(il + 32 * ch + 16 * u + 4 * g);
#pragma unroll
            for (int r = 0; r < 4; ++r) { const unsigned key = (r < 2 ? (kk[0] >> (16 * r)) : (kk[1] >> (16 * (r - 2)))) & 0xFFFFu;
                const bool ok = key <= (unsigned)t; const int dist = ok ? (t - (int)key) : 0; const int bucket = dist < 128 ? (int)t5[dist] : 31;
                const float v = ok ? lacc[u][r] + rb[bucket * 8 + (n16 & 7)] : -1e30f; lg[4 * u + r] = v; cm = fmaxf(cm, v); } }
        cm = fmaxf(cm, __shfl_xor(cm, 16)); cm = fmaxf(cm, __shfl_xor(cm, 32));
        const float mnew = fmaxf(mrun, cm), alpha = ex2(mrun - mnew); mrun = mnew;
        float p[8], ps = 0.f;
#pragma unroll
        for (int j = 0; j < 8; ++j) { p[j] = ex2(lg[j] - mnew); ps += p[j]; }
        lsum = lsum * alpha + ps;
        const h8 pf = pack8(p[0], p[1], p[2], p[3], p[4], p[5], p[6], p[7]);
        if (g == 0) al[n16] = alpha;
        LDS_WAIT(); CFENCE();
        const f32x4 av = *(const LAS f32x4*)(al + 4 * g);
#pragma unroll
        for (int nt = 0; nt < 8; ++nt) {
            oacc[nt] = oacc[nt] * av;
            const LAS unsigned char* a0 = kvb + (4 * g + ((lane >> 2) & 3)) * GA_PITCH + 32 * nt + 8 * (lane & 3);
            const h8 vf = tr_pair(a0, a0 + 16 * GA_PITCH);
            oacc[nt] = __builtin_amdgcn_mfma_f32_16x16x32_f16(pf, vf, oacc[nt], 0, 0, 0);
        }
        CFENCE();
    }
    lsum += __shfl_xor(lsum, 16); lsum += __shfl_xor(lsum, 32);
    if (g == 0) al[n16] = 1.f / lsum;
    LDS_WAIT(); CFENCE();
    const f32x4 iv = *(const LAS f32x4*)(al + 4 * g);
    if (g < 2) {
#pragma unroll
        for (int nt = 0; nt < 8; ++nt)
#pragma unroll
            for (int r = 0; r < 4; ++r) *(LAS half_t*)(kvb + ((4 * g + r) * 128 + 16 * nt + n16) * 2) = (half_t)(oacc[nt][r] * iv[r]);
    }
    LDS_WAIT(); CFENCE();
#pragma unroll
    for (int i = 0; i < 2; ++i) *(h8*)(YA + (size_t)row * 1024 + (i * 64 + lane) * 8) = *(const LAS h8*)(kvb + (i * 64 + lane) * 16);
    LDS_WAIT(); CFENCE();
}

__device__ __forceinline__ void xa_job(Frame& F, const half_t* XQ, const half_t* XK, const half_t* XVT, half_t* XO, int job) {
    const int lane = F.lane, r = lane & 31, hk = lane >> 5;
    const int qb = job & 127, hd = (job >> 7) & 3, b = job >> 9;
    const size_t qrow = (size_t)b * S + qb * 32 + r;
    h8 qf[8];
#pragma unroll
    for (int st = 0; st < 8; ++st) qf[st] = *(const h8*)(XQ + qrow * 512 + hd * 128 + 16 * st + 8 * hk);
    f32x16 oacc[4];
#pragma unroll
    for (int c = 0; c < 4; ++c)
#pragma unroll
        for (int i = 0; i < 16; ++i) oacc[c][i] = 0.f;
    float mrun = -1e30f, lsum = 0.f;
#pragma unroll 1
    for (int kt = 0; kt < 8; ++kt) {
        f32x16 sacc;
#pragma unroll
        for (int i = 0; i < 16; ++i) sacc[i] = 0.f;
#pragma unroll
        for (int st = 0; st < 8; ++st) { const h8 kf = *(const h8*)(XK + ((size_t)b * 256 + kt * 32 + r) * 512 + hd * 128 + 16 * st + 8 * hk);
            sacc = __builtin_amdgcn_mfma_f32_32x32x16_f16(kf, qf[st], sacc, 0, 0, 0); }
        float cm = sacc[0];
#pragma unroll
        for (int i = 1; i < 16; ++i) cm = fmaxf(cm, sacc[i]);
        cm = fmaxf(cm, __shfl_xor(cm, 32));
        const float mnew = fmaxf(mrun, cm), alpha = ex2(mrun - mnew); mrun = mnew;
        float p[16], ps = 0.f;
#pragma unroll
        for (int i = 0; i < 16; ++i) { p[i] = ex2(sacc[i] - mnew); ps += p[i]; }
        lsum = lsum * alpha + ps;
        const h8 pf0 = pack8(p[0], p[1], p[2], p[3], p[4], p[5], p[6], p[7]), pf1 = pack8(p[8], p[9], p[10], p[11], p[12], p[13], p[14], p[15]);
#pragma unroll
        for (int c = 0; c < 4; ++c) {
#pragma unroll
            for (int i = 0; i < 16; ++i) oacc[c][i] *= alpha;
#pragma unroll
            for (int s2 = 0; s2 < 2; ++s2) { const h8 vf = *(const h8*)(XVT + (size_t)(hd * 128 + 32 * c + r) * 2048 + b * 256 + kt * 32 + 16 * s2 + 8 * hk);
                oacc[c] = __builtin_amdgcn_mfma_f32_32x32x16_f16(vf, s2 ? pf1 : pf0, oacc[c], 0, 0, 0); }
        }
    }
    lsum += __shfl_xor(lsum, 32);
    const float inv = 1.f / lsum;
    half_t* orow = XO + qrow * 512 + hd * 128;
#pragma unroll
    for (int c = 0; c < 4; ++c)
#pragma unroll
        for (int q = 0; q < 4; ++q) *(h4*)(orow + 32 * c + 8 * q + 4 * hk) = pack4(oacc[c][4 * q] * inv, oacc[c][4 * q + 1] * inv, oacc[c][4 * q + 2] * inv, oacc[c][4 * q + 3] * inv);
}
#ifndef MK_N_LAUNCHES
#define MK_N_LAUNCHES 1
#endif
constexpr int NSLOT = 21, NPHASE = DEPTH * NSLOT;
struct Args { const float* in[18]; float* out; unsigned char* ws; int ph_lo, ph_hi; };
__global__ void __launch_bounds__(NWAVES * 64, 2) fwd(Args args) {
    extern __shared__ __attribute__((aligned(16))) unsigned char lds_raw[];
    Frame F;
    F.lds = (LAS unsigned char*)lds_raw;
    F.tid = threadIdx.x; F.lane = F.tid & 63; F.wave = __builtin_amdgcn_readfirstlane(F.tid >> 6);
    F.G = gridDim.x; { const int bx = blockIdx.x; F.vcu = (F.G % 8 == 0) ? (bx % 8) * (F.G / 8) + bx / 8 : bx; }
    F.x_in = args.in[0]; F.mem = args.in[1]; F.ln_g = args.in[2]; F.ln_b = args.in[3]; F.ffn_w_in = args.in[4]; F.ffn_w_out = args.in[5]; F.w_mix_in = args.in[6]; F.b_gate = args.in[7];
    F.kv_g = args.in[8]; F.w_uk = args.in[9]; F.w_uv = args.in[10]; F.conv_w = args.in[11]; F.w_branch = args.in[12]; F.w_mix_out = args.in[13]; F.xa_wq = args.in[14]; F.xa_wkv = args.in[15];
    F.xa_wo = args.in[16]; F.rel_bias = args.in[17];
    F.ws = args.ws; F.dout = (unsigned char*)args.out;
    unsigned char* ws = args.ws;
    for (int u = F.tid; u < (LDS_BYTES - LDSCTL_OFF) / 4; u += NWAVES * 64) ((LAS unsigned*)(F.lds + LDSCTL_OFF))[u] = 0u;
    __syncthreads();
    const int lo = args.ph_lo, hi = args.ph_hi;
    XcdBarrier bar; bar.bar = (unsigned*)(ws + WS_CTL) + CW_BAR; bar.x = 0; bar.st = nullptr;
    if (hi - lo > 1) bar = xcd_barrier_post((unsigned*)(ws + WS_CTL) + CW_BAR, (volatile LAS unsigned*)(F.lds + MISC_OFF) + 8);
#define RUN(gp) ((gp) >= lo && (gp) < hi && ((F.tid = opaque_tid()), (F.lane = F.tid & 63), true))
#define SEAM(gp) do { if ((gp) >= lo && (gp) + 1 < hi) xcd_barrier(bar); } while (0)

    half_t* const X = (half_t*)(ws + WS_X);
    half_t* const WFIN = (half_t*)(ws + WS_WFIN); half_t* const WFOUT = (half_t*)(ws + WS_WFOUT); half_t* const WMIX = (half_t*)(ws + WS_WMIX);
    half_t* const WBRA = (half_t*)(ws + WS_WBRA); half_t* const WBRB = (half_t*)(ws + WS_WBRB); half_t* const WBRC = (half_t*)(ws + WS_WBRC);
    half_t* const WMO = (half_t*)(ws + WS_WMO); half_t* const WXQ = (half_t*)(ws + WS_WXQ); half_t* const WXKV = (half_t*)(ws + WS_WXKV); half_t* const WXO = (half_t*)(ws + WS_WXO);
    half_t* const MEMH = (half_t*)(ws + WS_MEMH); half_t* const MEMP = (half_t*)(ws + WS_MEMP);
    half_t* const XK = (half_t*)(ws + WS_XK); half_t* const XVT = (half_t*)(ws + WS_XVT);
    half_t* const CKVN = (half_t*)(ws + WS_CKVN); unsigned short* const IDX = (unsigned short*)(ws + WS_IDX); float* const SCR = (float*)(ws + WS_SCR);
    half_t* const MIX = (half_t*)(ws + WS_BIG); half_t* const H = (half_t*)(ws + WS_BIG); float* const VBIG = (float*)(ws + WS_BIG);
    half_t* const XQ = (half_t*)(ws + WS_BIG); half_t* const XO = (half_t*)(ws + WS_BIG + 32 * MiB);
    half_t* const YA = (half_t*)(F.dout + DO_YA); half_t* const YB = (half_t*)(F.dout + DO_YB); half_t* const YC = (half_t*)(F.dout + DO_YC); half_t* const MG = (half_t*)(F.dout + DO_MG);
    float* const VOUT = (float*)F.dout;
    const int cid = (int)blockIdx.x;

    for (int l = 0; l < DEPTH; ++l) {
        const int g0 = l * NSLOT;
        if (RUN(g0)) { p_prep(F, l); if (l == 0) p_x_to_half(F); }
        SEAM(g0);
        for (int which = 0; which < 2; ++which) {
            const int sb = g0 + (which ? 18 : 1);
            if (RUN(sb)) {
                { pg8::Gemm g{X, WFIN + (size_t)which * 5632 * 1024, M, 2 * DFF, D}; pg8::StaticOrder So; So.init(M, 2 * DFF, F.G, cid);
                  pg8::EpiSwiGLU E{H, DFF}; pg8::gemm_phase(F.lds, g, So, E); }
                if (which == 0) {
                    { pg8::Gemm g{MEMH, WXKV, NB * MEM, 512, D}; pg8::StaticOrder So; So.init(NB * MEM, 512, F.G, cid);
                      pg8::EpiH E{XK, 512, nullptr, 0, 0}; pg8::gemm_phase(F.lds, g, So, E); }
                    { pg8::Gemm g{WXKV + (size_t)512 * 1024, MEMP, 512, NB * MEM, D}; pg8::StaticOrder So; So.init(512, NB * MEM, F.G, cid);
                      pg8::EpiH E{XVT, NB * MEM, nullptr, 0, 0}; pg8::gemm_phase(F.lds, g, So, E); }
                }
            }
            SEAM(sb);
            if (RUN(sb + 1)) { pg8::Gemm g{H, WFOUT + (size_t)which * 1024 * DFF, M, D, DFF}; pg8::StaticOrder So; So.init(M, D, F.G, cid);
                pg8::EpiRes E{X, VOUT, 0.5f}; pg8::gemm_phase(F.lds, g, So, E); }
            SEAM(sb + 1);
            if (RUN(sb + 2)) { const int li = which ? 3 : 0; p_ln(F, VOUT, F.ln_g + (size_t)(l * 4 + li) * D, F.ln_b + (size_t)(l * 4 + li) * D, (which == 1 && l == DEPTH - 1) ? VOUT : nullptr); }
            SEAM(sb + 2);
            if (which == 0) {
                for (int c = 0; c < NCHUNK; ++c) {
                    const int gm = g0 + 4 + 4 * c;
                    if (RUN(gm)) { pg8::Gemm g{X + (size_t)c * CH_ROWS * D, WMIX, CH_ROWS, NMIX, D}; pg8::StaticOrder So; So.init(CH_ROWS, NMIX, F.G, cid);
                        pg8::EpiH E{MIX, NMIX, (const float*)(ws + WS_BIAS), 18, 30}; pg8::gemm_phase(F.lds, g, So, E); }
                    SEAM(gm);
                    if (RUN(gm + 1)) {
                        for (int k = F.vcu; k < CH_B * 256; k += F.G) idx_job(F, MIX, IDX, SCR, ((k & 3) << 8) | (255 - (k >> 2)));
                        for (int j = F.vcu * NWAVES + F.wave; j < CH_B * 8 * 128; j += F.G * NWAVES) sb_job(F, MIX, YB, j);
                        for (int j = F.vcu * NWAVES + F.wave; j < CH_ROWS / 4; j += F.G * NWAVES) rms_job(F, MIX, CKVN, F.kv_g + (size_t)l * 128, j);
                        for (int j = F.vcu * NWAVES + F.wave; j < CH_ROWS / 64; j += F.G * NWAVES) conv_job(F, MIX, YC, F.conv_w + (size_t)l * 3 * 512, j);
                    }
                    SEAM(gm + 1);
                    if (RUN(gm + 2)) {
                        ga_tables(F);
                        const int per = (CH_ROWS + F.G - 1) / F.G, r0 = F.vcu * per, r1 = (r0 + per) < CH_ROWS ? (r0 + per) : CH_ROWS;
                        for (int row = r0 + F.wave; row < r1; row += NWAVES) ga_job(F, MIX, CKVN, IDX, YA, row);
                    }
                    SEAM(gm + 2);
                    if (RUN(gm + 3)) {
                        half_t* mgc = MG + (size_t)c * CH_ROWS * D;
                        { pg8::Gemm g{YA, WBRA, CH_ROWS, D, 1024}; pg8::StaticOrder So; So.init(CH_ROWS, D, F.G, cid); pg8::EpiGate<true> E{MIX + C_G, NMIX, mgc}; pg8::gemm_phase(F.lds, g, So, E); }
                        { pg8::Gemm g{YB, WBRB, CH_ROWS, D, 512}; pg8::StaticOrder So; So.init(CH_ROWS, D, F.G, cid); pg8::EpiGate<false> E{MIX + C_G + 1024, NMIX, mgc}; pg8::gemm_phase(F.lds, g, So, E); }
                        { pg8::Gemm g{YC, WBRC, CH_ROWS, D, 512}; pg8::StaticOrder So; So.init(CH_ROWS, D, F.G, cid); pg8::EpiGate<false> E{MIX + C_G + 2048, NMIX, mgc}; pg8::gemm_phase(F.lds, g, So, E); }
                    }
                    SEAM(gm + 3);
                }
                if (RUN(g0 + 12)) { pg8::Gemm g{MG, WMO, M, D, D}; pg8::StaticOrder So; So.init(M, D, F.G, cid); pg8::EpiRes E{X, VBIG, 1.0f}; pg8::gemm_phase(F.lds, g, So, E); }
                SEAM(g0 + 12);
                if (RUN(g0 + 13)) p_ln(F, VBIG, F.ln_g + (size_t)(l * 4 + 1) * D, F.ln_b + (size_t)(l * 4 + 1) * D, nullptr);
                SEAM(g0 + 13);
                if (RUN(g0 + 14)) { pg8::Gemm g{X, WXQ, M, 512, D}; pg8::StaticOrder So; So.init(M, 512, F.G, cid); pg8::EpiH E{XQ, 512, nullptr, 0, 0}; pg8::gemm_phase(F.lds, g, So, E); }
                SEAM(g0 + 14);
                if (RUN(g0 + 15)) { for (int j = F.vcu * NWAVES + F.wave; j < NB * 4 * 128; j += F.G * NWAVES) xa_job(F, XQ, XK, XVT, XO, j); }
                SEAM(g0 + 15);
                if (RUN(g0 + 16)) { pg8::Gemm g{XO, WXO, M, D, 512}; pg8::StaticOrder So; So.init(M, D, F.G, cid); pg8::EpiRes E{X, VOUT, 1.0f}; pg8::gemm_phase(F.lds, g, So, E); }
                SEAM(g0 + 16);
                if (RUN(g0 + 17)) p_ln(F, VOUT, F.ln_g + (size_t)(l * 4 + 2) * D, F.ln_b + (size_t)(l * 4 + 2) * D, nullptr);
                SEAM(g0 + 17);
            }
        }
    }
#undef RUN
#undef SEAM
}

extern "C" void kernel_launch(void* const* d_in, const int* in_sizes, int n_in, void* d_out, int out_size, void* d_ws, size_t ws_size, hipStream_t stream) {
    static int grid = 0;
    if (grid == 0) {
        if (n_in != 18 || out_size != M * D || ws_size < WS_END) { fprintf(stderr, "kernel_launch: unexpected shapes (n_in %d out %d ws %zu need %zu)\n", n_in, out_size, ws_size, (size_t)WS_END); grid = -1; return; }
        int dev = 0, cus = 0, per_cu = 0;
        if (hipGetDevice(&dev) != hipSuccess || hipDeviceGetAttribute(&cus, hipDeviceAttributeMultiprocessorCount, dev) != hipSuccess) { grid = -1; return; }
        if (hipFuncSetAttribute((const void*)fwd, hipFuncAttributeMaxDynamicSharedMemorySize, LDS_BYTES) != hipSuccess) { fprintf(stderr, "kernel_launch: hipFuncSetAttribute failed\n"); grid = -1; return; }
        if (hipOccupancyMaxActiveBlocksPerMultiprocessor(&per_cu, (const void*)fwd, NWAVES * 64, LDS_BYTES) != hipSuccess || per_cu < 1) { fprintf(stderr, "kernel_launch: occupancy query says %d\n", per_cu); }
        (void)hipGetLastError();
        grid = cus;
    }
    if (grid < 0) return;
    if (hipMemsetAsync((char*)d_ws + WS_CTL, 0, CTL_ZERO_BYTES, stream) != hipSuccess) return;
    Args a{};
    for (int i = 0; i < 18; ++i) a.in[i] = (const float*)d_in[i];
    a.out = (float*)d_out; a.ws = (unsigned char*)d_ws;
#if MK_N_LAUNCHES == 1
    a.ph_lo = 0; a.ph_hi = NPHASE;
    hipLaunchKernelGGL(fwd, dim3(grid), dim3(NWAVES * 64), LDS_BYTES, stream, a);
#else
    for (int p = 0; p < NPHASE; ++p) { a.ph_lo = p; a.ph_hi = p + 1; hipLaunchKernelGGL(fwd, dim3(grid), dim3(NWAVES * 64), LDS_BYTES, stream, a); }
#endif
}
```

```cpp
#define MK_N_LAUNCHES 1
#include <hip/hip_runtime.h>
#include <cstdio>
#include <cstdint>

#define LAS __attribute__((address_space(3)))
#define GAS __attribute__((address_space(1)))
typedef _Float16 half_t;
typedef _Float16 h8 __attribute__((ext_vector_type(8)));
typedef _Float16 h4 __attribute__((ext_vector_type(4)));
typedef _Float16 h2 __attribute__((ext_vector_type(2)));
typedef float f32x4 __attribute__((ext_vector_type(4)));
typedef float f32x16 __attribute__((ext_vector_type(16)));
typedef short s4v __attribute__((ext_vector_type(4)));
typedef short s8v __attribute__((ext_vector_type(8)));
typedef unsigned u32x4 __attribute__((ext_vector_type(4)));
typedef unsigned u32x2 __attribute__((ext_vector_type(2)));

constexpr int D = 1024, NB = 8, S = 4096, DEPTH = 2, MEM = 256, DFF = 2816, PT = 7368;
constexpr int M = NB * S;
constexpr int CH_ROWS = 16384, NCHUNK = 2, CH_B = 4;
constexpr int NMIX = 7936;
constexpr int O_QA = 0, O_CKV = 512, O_IQ = 640, O_IK = 1152, O_IW = 1216, O_QS = 1224, O_KS = 1736, O_VS = 2248, O_CB = 2760, O_CC = 3272, O_CH = 3784, O_GA = 4296;
constexpr int C_QL = 0, C_IQ = 1024, C_QS = 1536, C_KS = 2048, C_VS = 2560, C_CB = 3072, C_CC = 3584, C_CH = 4096, C_G = 4608, C_CKV = 7680, C_IK = 7808, C_IW = 7872;
constexpr float ALPHA = 1.4142135623730951f, LN_EPS = 1e-5f, LOG2E = 1.4426950408889634f;

struct T5Tab { unsigned char v[128]; };
constexpr T5Tab make_t5() {
    T5Tab t{};
    for (int n = 0; n < 128; ++n) {
        if (n < 16) { t.v[n] = (unsigned char)n; continue; }
        unsigned __int128 p = 1; for (int i = 0; i < 16; ++i) p *= (unsigned __int128)n;
        int k = 0; for (int kk = 0; kk <= 15; ++kk) { if (p >= ((unsigned __int128)1 << (3 * kk + 64))) k = kk; }
        int bk = 16 + k; if (bk > 31) bk = 31; t.v[n] = (unsigned char)bk;
    }
    return t;
}
__device__ const T5Tab T5 = make_t5();

constexpr size_t MiB = 1u << 20;
constexpr size_t WS_CTL = 0, CTL_ZERO_BYTES = 1 * MiB;
constexpr size_t WS_WL = 1 * MiB, WL_STRIDE = 60 * MiB;
constexpr size_t WL_WFIN = 0;
constexpr size_t WL_WFOUT = WL_WFIN + 22 * MiB;
constexpr size_t WL_WMIX = WL_WFOUT + 11 * MiB;
constexpr size_t WL_WBRA = WL_WMIX + 16 * MiB;
constexpr size_t WL_WBRB = WL_WBRA + 2 * MiB;
constexpr size_t WL_WBRC = WL_WBRB + 1 * MiB;
constexpr size_t WL_WMO = WL_WBRC + 1 * MiB;
constexpr size_t WL_WXQ = WL_WMO + 2 * MiB;
constexpr size_t WL_WXKV = WL_WXQ + 1 * MiB;
constexpr size_t WL_WXO = WL_WXKV + 2 * MiB;
constexpr size_t WL_BIAS = WL_WXO + 1 * MiB;
static_assert(WL_BIAS + 1 * MiB <= WL_STRIDE, "layer weight block");
constexpr size_t WS_MEMH = WS_WL + 2 * WL_STRIDE;
constexpr size_t WS_MEMP = WS_MEMH + 4 * MiB;
constexpr size_t WS_SMALL = WS_MEMP + 4 * MiB;
constexpr size_t SM_LNG = 0, SM_LNB = 32768, SM_KVG = 65536, SM_CONV = 65536 + 1024, SM_RB = 65536 + 1024 + 24576;
constexpr size_t WS_XK = WS_SMALL + 1 * MiB;
constexpr size_t WS_XVT = WS_XK + 2 * MiB;
constexpr size_t WS_X = WS_XVT + 2 * MiB;
constexpr size_t WS_CKVN = WS_X + 64 * MiB;
constexpr size_t WS_IDX = WS_CKVN + 4 * MiB;
constexpr size_t WS_BIG = WS_IDX + 8 * MiB;
constexpr size_t WS_END = WS_BIG + 248 * MiB;
static_assert(WS_END <= 512 * MiB, "workspace map");
constexpr size_t DO_MG = 0, DO_YA = 64 * MiB, DO_YB = 96 * MiB, DO_YC = 112 * MiB, DO_SCR = 32 * MiB;
constexpr int CW_BAR = 4096;

constexpr int RING_BYTES = 131072, LDSCTL_OFF = RING_BYTES, MISC_OFF = LDSCTL_OFF + 320, LDS_BYTES = 147456;
constexpr int NWAVES = 8;

#define LDS_WAIT() asm volatile("s_waitcnt lgkmcnt(0)" ::: "memory")
#define VM_WAIT() asm volatile("s_waitcnt vmcnt(0)" ::: "memory")
#define CFENCE() asm volatile("" ::: "memory")

__device__ __forceinline__ h8 pack8(float a0, float a1, float a2, float a3, float a4, float a5, float a6, float a7) {
    h8 r; r[0] = (half_t)a0; r[1] = (half_t)a1; r[2] = (half_t)a2; r[3] = (half_t)a3; r[4] = (half_t)a4; r[5] = (half_t)a5; r[6] = (half_t)a6; r[7] = (half_t)a7; return r;
}
__device__ __forceinline__ h4 pack4(float a0, float a1, float a2, float a3) { h4 r; r[0] = (half_t)a0; r[1] = (half_t)a1; r[2] = (half_t)a2; r[3] = (half_t)a3; return r; }
__device__ __forceinline__ int opaque_lane() { int x; asm volatile("v_mbcnt_lo_u32_b32 %0, -1, 0\n\tv_mbcnt_hi_u32_b32 %0, -1, %0" : "=v"(x)); return x; }
__device__ __forceinline__ int opaque_tid() { const int w = __builtin_amdgcn_readfirstlane((int)threadIdx.x >> 6); return w * 64 + opaque_lane(); }
__device__ __forceinline__ float ex2(float x) { return __builtin_amdgcn_exp2f(x); }
__device__ __forceinline__ float lg2(float x) { return __builtin_amdgcn_logf(x); }

namespace pg8 {
constexpr int BM = 256, BK = 64, HALF = 128, HTB = HALF * BK * 2, STAGE_BYTES = 8 * HTB, NXCD = 8, WGM = 8;
__host__ __device__ __forceinline__ int lds_byte(int r, int c) { const int st = (r >> 4) * 2 + (c >> 5), rr = r & 15, cc = c & 31, ob = rr * 64 + cc * 2; return st * 1024 + (ob ^ (((ob >> 9) & 1) << 5)); }
__host__ __device__ __forceinline__ void stage_rc(int b, int& R, int& C) { const int st = b / 1024, sb = b % 1024, swz = sb ^ (((sb >> 9) & 1) << 5); R = (st >> 1) * 16 + swz / 64; C = (st & 1) * 32 + (swz % 64) / 2; }
__host__ __device__ __forceinline__ int perm32(int rho) { const int n = rho >> 4, i = rho & 15; return 8 * (i >> 2) + 4 * n + (i & 3); }
struct Unit { int pm, pn; };
struct Gemm { const half_t* A; const half_t* Bt; int M, N, K; };
struct StaticOrder {
    int nM, nN, nwg, G, c;
    __host__ __device__ void init(int M_, int N_, int G_, int c_) { nM = M_ / BM; nN = N_ / BM; nwg = nM * nN; G = G_; c = c_; }
    __host__ __device__ bool next(int i, Unit& u) const {
        const long L = (long)i * G + c; if (L >= nwg) return false;
        int wgid = (int)L; { const int q = nwg / NXCD, r = nwg % NXCD, xcd = wgid % NXCD, off = wgid / NXCD; wgid = (xcd < r ? xcd * (q + 1) : r * (q + 1) + (xcd - r) * q) + off; }
        const int nig = WGM * nN, gid = wgid / nig, fm = gid * WGM, gsz = (nM - fm) < WGM ? (nM - fm) : WGM;
        u.pm = fm + ((wgid % nig) % gsz); u.pn = (wgid % nig) / gsz; return true;
    }
    __device__ __forceinline__ void a_ready(const Unit&) const {}
    __device__ __forceinline__ void done(const Unit&) const {}
};
typedef f32x4 Acc[2][2][4][2];

struct EpiH {
    half_t* O; int ldc; const float* bias; int sig_lo, sig_hi;
    __device__ __forceinline__ void operator()(const Acc& acc, const Unit& u, int wr, int wc, int fr, int fq) const {
        const int row0 = u.pm * BM + wr * 64 + fr, col0 = u.pn * BM + wc * 32 + 8 * fq;
        const bool sig = u.pn >= sig_lo && u.pn < sig_hi;
        f32x4 bv[2][2];
#pragma unroll
        for (int bj = 0; bj < 2; ++bj)
#pragma unroll
            for (int n = 0; n < 2; ++n) bv[bj][n] = bias ? *(const f32x4*)(bias + col0 + bj * HALF + 4 * n) : (f32x4){0.f, 0.f, 0.f, 0.f};
#pragma unroll
        for (int ai = 0; ai < 2; ++ai)
#pragma unroll
            for (int m = 0; m < 4; ++m) { half_t* rowp = O + (size_t)(row0 + ai * HALF + m * 16) * ldc + col0;
#pragma unroll
                for (int bj = 0; bj < 2; ++bj) { f32x4 v0 = acc[ai][bj][m][0] + bv[bj][0], v1 = acc[ai][bj][m][1] + bv[bj][1];
                    if (sig) {
#pragma unroll
                        for (int j = 0; j < 4; ++j) { v0[j] = __builtin_amdgcn_rcpf(1.f + ex2(-LOG2E * v0[j])); v1[j] = __builtin_amdgcn_rcpf(1.f + ex2(-LOG2E * v1[j])); } }
                    *(h8*)(rowp + bj * HALF) = pack8(v0[0], v0[1], v0[2], v0[3], v1[0], v1[1], v1[2], v1[3]); } }
    }
};
struct EpiSwiGLU {
    half_t* O; int ldc;
    __device__ __forceinline__ void operator()(const Acc& acc, const Unit& u, int wr, int wc, int fr, int fq) const {
        const int row0 = u.pm * BM + wr * 64 + fr, col0 = u.pn * HALF + wc * 32 + 8 * fq;
#pragma unroll
        for (int ai = 0; ai < 2; ++ai)
#pragma unroll
            for (int m = 0; m < 4; ++m) { half_t* rowp = O + (size_t)(row0 + ai * HALF + m * 16) * ldc + col0; float o[8];
#pragma unroll
                for (int n = 0; n < 2; ++n)
#pragma unroll
                    for (int j = 0; j < 4; ++j) { const float a = acc[ai][0][m][n][j], b = acc[ai][1][m][n][j]; o[4 * n + j] = a * __builtin_amdgcn_rcpf(1.f + ex2(-LOG2E * a)) * b; }
                *(h8*)rowp = pack8(o[0], o[1], o[2], o[3], o[4], o[5], o[6], o[7]); }
    }
};
struct EpiRes {
    const half_t* X; half_t* V; float s;
    __device__ __forceinline__ void operator()(const Acc& acc, const Unit& u, int wr, int wc, int fr, int fq) const {
        const int row0 = u.pm * BM + wr * 64 + fr, col0 = u.pn * BM + wc * 32 + 8 * fq;
#pragma unroll
        for (int ai = 0; ai < 2; ++ai)
#pragma unroll
            for (int m = 0; m < 4; ++m) { const size_t off = (size_t)(row0 + ai * HALF + m * 16) * D + col0;
#pragma unroll
                for (int bj = 0; bj < 2; ++bj) { const h8 xv = *(const h8*)(X + off + bj * HALF); float o[8];
#pragma unroll
                    for (int j = 0; j < 4; ++j) { o[j] = ALPHA * (float)xv[j] + s * acc[ai][bj][m][0][j]; o[4 + j] = ALPHA * (float)xv[4 + j] + s * acc[ai][bj][m][1][j]; }
                    *(h8*)(V + off + bj * HALF) = pack8(o[0], o[1], o[2], o[3], o[4], o[5], o[6], o[7]); } }
    }
};
template <bool FIRST> struct EpiGate {
    const half_t* G; int ldg; half_t* MG;
    __device__ __forceinline__ void operator()(const Acc& acc, const Unit& u, int wr, int wc, int fr, int fq) const {
        const int row0 = u.pm * BM + wr * 64 + fr, col0 = u.pn * BM + wc * 32 + 8 * fq;
#pragma unroll
        for (int ai = 0; ai < 2; ++ai)
#pragma unroll
            for (int m = 0; m < 4; ++m) { const int row = row0 + ai * HALF + m * 16;
#pragma unroll
                for (int bj = 0; bj < 2; ++bj) { const h8 gv = *(const h8*)(G + (size_t)row * ldg + col0 + bj * HALF); half_t* mp = MG + (size_t)row * D + col0 + bj * HALF; float o[8];
#pragma unroll
                    for (int j = 0; j < 4; ++j) { o[j] = (float)gv[j] * acc[ai][bj][m][0][j]; o[4 + j] = (float)gv[4 + j] * acc[ai][bj][m][1][j]; }
                    if (!FIRST) { const h8 pv = *(const h8*)mp;
#pragma unroll
                        for (int j = 0; j < 8; ++j) o[j] += (float)pv[j]; }
                    *(h8*)mp = pack8(o[0], o[1], o[2], o[3], o[4], o[5], o[6], o[7]); } }
    }
};

template <class Epi, class Sched>
__device__ __forceinline__ void gemm_phase(LAS unsigned char* lds, const Gemm g, const Sched& Sd, const Epi& E, int wid) {
    const int lane = opaque_lane(), tid = wid * 64 + lane, wr = wid >> 2, wc = wid & 3, fr = lane & 15, fq = lane >> 4;
    const int K = g.K, nt = K / BK;
    unsigned voffA[2], voffB[2];
#pragma unroll
    for (int i = 0; i < 2; ++i) { int R, C; stage_rc(tid * 16 + i * 8192, R, C); const int Rb = (R & ~31) + perm32(R & 31);
        voffA[i] = (unsigned)(R * K + C) * 2u; voffB[i] = (unsigned)(Rb * K + C) * 2u; }
    const size_t kstep = (size_t)(BK * 2);
    const size_t hstep = (size_t)HALF * K * 2;
    const size_t tstep = 2 * hstep;
    const unsigned ldsw = (unsigned)wid * 1024u;
    const int aoff = lds_byte(wr * 64 + fr, fq * 8), boff = lds_byte(wc * 32 + fr, fq * 8);
#define PG8_SA(b, h) (((b) * 2 + (h)) * HTB)
#define PG8_SB(b, h) ((4 + (b) * 2 + (h)) * HTB)
#define PG8_STAGE(bufoff, gbase, voff) do { _Pragma("unroll") for (int _i = 0; _i < 2; ++_i) \
        __builtin_amdgcn_global_load_lds((const unsigned*)((const char*)(gbase) + (voff)[_i]), (LAS unsigned*)(lds + (bufoff) + ldsw + _i * 8192), 16, 0, 0); } while (0)
#define PG8_LDA(dst, b, h) do { _Pragma("unroll") for (int m = 0; m < 4; ++m) _Pragma("unroll") for (int k = 0; k < 2; ++k) dst[m][k] = *(const LAS h8*)(lds + PG8_SA(b, h) + aoff + m * 2048 + k * 1024); } while (0)
#define PG8_LDB(dst, b, h) do { _Pragma("unroll") for (int n = 0; n < 2; ++n) _Pragma("unroll") for (int k = 0; k < 2; ++k) dst[n][k] = *(const LAS h8*)(lds + PG8_SB(b, h) + boff + n * 2048 + k * 1024); } while (0)
#define PG8_MMA(ai, bj, At, Bt) do { __builtin_amdgcn_s_setprio(1); _Pragma("unroll") for (int m = 0; m < 4; ++m) _Pragma("unroll") for (int n = 0; n < 2; ++n) _Pragma("unroll") for (int k = 0; k < 2; ++k) \
        acc[ai][bj][m][n] = __builtin_amdgcn_mfma_f32_16x16x32_f16(Bt[n][k], At[m][k], acc[ai][bj][m][n], 0, 0, 0); __builtin_amdgcn_s_setprio(0); } while (0)
#define PG8_WAIT_V(n) asm volatile("s_waitcnt vmcnt(" #n ")" ::: "memory")
#define PG8_WAIT_L(n) asm volatile("s_waitcnt lgkmcnt(" #n ")" ::: "memory")
#define PG8_BAR __builtin_amdgcn_s_barrier()
#define PG8_SCHED __builtin_amdgcn_sched_barrier(0)
    Unit cur, nxt; int ui = 0;
    if (!Sd.next(0, cur)) return;
    Acc acc;
#pragma unroll
    for (int a = 0; a < 2; ++a)
#pragma unroll
        for (int b = 0; b < 2; ++b)
#pragma unroll
            for (int m = 0; m < 4; ++m)
#pragma unroll
                for (int n = 0; n < 2; ++n) acc[a][b][m][n] = (f32x4){0.f, 0.f, 0.f, 0.f};
    h8 At[4][2], B0[2][2], B1[2][2];
    const char* cA = (const char*)g.A + (size_t)cur.pm * tstep; const char* cB = (const char*)g.Bt + (size_t)cur.pn * tstep;
    Sd.a_ready(cur);
    PG8_STAGE(PG8_SB(0, 0), cB, voffB); PG8_STAGE(PG8_SA(0, 0), cA, voffA); PG8_STAGE(PG8_SB(0, 1), cB + hstep, voffB); PG8_STAGE(PG8_SA(0, 1), cA + hstep, voffA);
    if (wr == 1) PG8_BAR;
    PG8_WAIT_V(4); PG8_BAR;
    PG8_STAGE(PG8_SB(1, 0), cB + kstep, voffB); PG8_STAGE(PG8_SA(1, 0), cA + kstep, voffA); PG8_STAGE(PG8_SB(1, 1), cB + hstep + kstep, voffB);
    PG8_WAIT_V(6); PG8_BAR;
    for (;;) {
        const bool has_next = Sd.next(ui + 1, nxt);
        const char* nA = has_next ? (const char*)g.A + (size_t)nxt.pm * tstep : cA; const char* nB = has_next ? (const char*)g.Bt + (size_t)nxt.pn * tstep : cB;
        for (int t = 0; t < nt; t += 2) {
            const bool last = (t == nt - 2);
            const char* a1 = cA + (size_t)(t + 1) * kstep;
            const char* a2 = last ? nA : cA + (size_t)(t + 2) * kstep; const char* b2 = last ? nB : cB + (size_t)(t + 2) * kstep;
            const char* a3 = a2 + kstep; const char* b3 = b2 + kstep;
            if (last && has_next) Sd.a_ready(nxt);
            PG8_LDB(B0, 0, 0); PG8_SCHED; PG8_LDA(At, 0, 0); PG8_STAGE(PG8_SA(1, 1), a1 + hstep, voffA);
            PG8_WAIT_L(8); PG8_BAR; PG8_WAIT_L(0); PG8_MMA(0, 0, At, B0); PG8_BAR; PG8_SCHED;
            PG8_LDB(B1, 0, 1); PG8_STAGE(PG8_SB(0, 0), b2, voffB);
            PG8_BAR; PG8_WAIT_L(0); PG8_MMA(0, 1, At, B1); PG8_BAR;
            PG8_LDA(At, 0, 1); PG8_STAGE(PG8_SA(0, 0), a2, voffA);
            PG8_BAR; PG8_WAIT_L(0); PG8_MMA(1, 0, At, B0); PG8_BAR; PG8_SCHED;
            PG8_STAGE(PG8_SB(0, 1), b2 + hstep, voffB);
            PG8_WAIT_V(6); PG8_BAR; PG8_MMA(1, 1, At, B1); PG8_BAR;
            PG8_LDB(B0, 1, 0); PG8_SCHED; PG8_LDA(At, 1, 0); PG8_STAGE(PG8_SA(0, 1), a2 + hstep, voffA);
            PG8_WAIT_L(8); PG8_BAR; PG8_WAIT_L(0); PG8_MMA(0, 0, At, B0); PG8_BAR; PG8_SCHED;
            PG8_LDB(B1, 1, 1); PG8_STAGE(PG8_SB(1, 0), b3, voffB);
            PG8_BAR; PG8_WAIT_L(0); PG8_MMA(0, 1, At, B1); PG8_BAR;
            PG8_LDA(At, 1, 1); PG8_STAGE(PG8_SA(1, 0), a3, voffA);
            PG8_BAR; PG8_WAIT_L(0); PG8_MMA(1, 0, At, B0); PG8_BAR; PG8_SCHED;
            PG8_STAGE(PG8_SB(1, 1), b3 + hstep, voffB);
            PG8_WAIT_V(6); PG8_BAR; PG8_MMA(1, 1, At, B1); PG8_BAR;
        }
        E(acc, cur, wr, wc, fr, fq); Sd.done(cur);
        if (!has_next) break;
#pragma unroll
        for (int a = 0; a < 2; ++a)
#pragma unroll
            for (int b = 0; b < 2; ++b)
#pragma unroll
                for (int m = 0; m < 4; ++m)
#pragma unroll
                    for (int n = 0; n < 2; ++n) acc[a][b][m][n] = (f32x4){0.f, 0.f, 0.f, 0.f};
        cur = nxt; cA = nA; cB = nB; ++ui;
    }
    PG8_WAIT_V(0);
    if (wr == 0) PG8_BAR;
    PG8_BAR;
#undef PG8_SA
#undef PG8_SB
#undef PG8_STAGE
#undef PG8_LDA
#undef PG8_LDB
#undef PG8_MMA
#undef PG8_WAIT_V
#undef PG8_WAIT_L
#undef PG8_BAR
#undef PG8_SCHED
}
}
#define XB_TMO      128
#define XB_XCNT(j)  (256  + 64 * (j))
#define XB_XSUB(j)  (1280 + 64 * (j))
#define XB_XGEN(j)  (2304 + 64 * (j))
#define XB_TOP      3328
#define XB_TOPGEN   3392
#define XCD_BAR_WORDS 3456
#define XB_SPIN_CAP (1u << 18)
__device__ __forceinline__ unsigned xb_ld(unsigned* p)              { return __hip_atomic_load(p, __ATOMIC_RELAXED, __HIP_MEMORY_SCOPE_AGENT); }
__device__ __forceinline__ unsigned xb_add(unsigned* p, unsigned v) { return __hip_atomic_fetch_add(p, v, __ATOMIC_RELAXED, __HIP_MEMORY_SCOPE_AGENT); }
__device__ __forceinline__ unsigned xb_xcc_id() { return (unsigned)__builtin_amdgcn_s_getreg((3 << 11) | 20) & 0xFu; }
#define XB_SPIN(cond, bar) do { unsigned _sp = 0; while (cond) { __builtin_amdgcn_s_sleep(1); \
    if ((++_sp & 255u) == 0u) { if (xb_ld(&(bar)[XB_TMO])) break; if (_sp > XB_SPIN_CAP) { atomicAdd(&(bar)[XB_TMO], 1u); break; } } } } while (0)
struct XcdBarrier { unsigned* bar; unsigned x; volatile LAS unsigned* st; int wave; };
__device__ __forceinline__ XcdBarrier xcd_barrier_post(unsigned* bar, volatile LAS unsigned* st, int wave) {
    XcdBarrier b; b.bar = bar; b.x = xb_xcc_id(); b.st = st; b.wave = wave;
    if (wave == 0 && opaque_lane() == 0) (void)xb_add(&bar[XB_XCNT(b.x)], 1u);
    return b;
}
__device__ __forceinline__ void xcd_barrier_complete(unsigned* bar, unsigned x, unsigned& nloc, unsigned& nx) {
    const unsigned G = gridDim.x * gridDim.y * gridDim.z;
    unsigned sum, cnt, mine, sp = 0u;
    for (;;) {
        sum = 0u; cnt = 0u; mine = 0u;
#pragma unroll
        for (unsigned j = 0; j < 16; ++j) { const unsigned c = xb_ld(&bar[XB_XCNT(j)]); sum += c; cnt += (c > 0u) ? 1u : 0u; mine = (j == x) ? c : mine; }
        if (sum == G) break;
        __builtin_amdgcn_s_sleep(1);
        if ((++sp & 255u) == 0u) { if (xb_ld(&bar[XB_TMO])) break; if (sp > XB_SPIN_CAP) { atomicAdd(&bar[XB_TMO], 1u); break; } }
    }
    nloc = mine > 0u ? mine : 1u; nx = cnt > 0u ? cnt : 1u;
}
__device__ __forceinline__ void xcd_barrier(const XcdBarrier& b) {
    asm volatile("s_waitcnt vmcnt(0)" ::: "memory");
    __syncthreads();
    if (b.wave == 0 && opaque_lane() == 0) {
        unsigned* bar = b.bar;
        __builtin_amdgcn_s_waitcnt(0);
        unsigned nloc = b.st[0], nx = b.st[1];
        if (nloc == 0u) { xcd_barrier_complete(bar, b.x, nloc, nx); b.st[0] = nloc; b.st[1] = nx; }
        const unsigned old = xb_add(&bar[XB_XSUB(b.x)], 1u);
        const unsigned gen = old / nloc;
        if (old + 1u == (gen + 1u) * nloc) {
            __builtin_amdgcn_fence(__ATOMIC_RELEASE, "agent");
            asm volatile("s_waitcnt vmcnt(0)" ::: "memory");
            const unsigned og = xb_add(&bar[XB_TOP], 1u);
            const unsigned tg = og / nx;
            if (og + 1u == (tg + 1u) * nx) xb_add(&bar[XB_TOPGEN], 1u);
            else XB_SPIN(xb_ld(&bar[XB_TOPGEN]) == tg, bar);
            __builtin_amdgcn_fence(__ATOMIC_ACQUIRE, "agent");
            xb_add(&bar[XB_XGEN(b.x)], 1u);
            asm volatile("s_waitcnt vmcnt(0)" ::: "memory");
        } else {
            XB_SPIN(xb_ld(&bar[XB_XGEN(b.x)]) == gen, bar);
            __builtin_amdgcn_fence(__ATOMIC_ACQUIRE, "agent");
            asm volatile("s_waitcnt vmcnt(0)" ::: "memory");
        }
    }
    __syncthreads();
}

struct Frame {
    LAS unsigned char* lds;
    int tid, lane, wave, vcu, G;
    const float *x_in, *mem, *ln_g, *ln_b, *ffn_w_in, *ffn_w_out, *w_mix_in, *b_gate, *kv_g, *w_uk, *w_uv, *conv_w, *w_branch, *w_mix_out, *xa_wq, *xa_wkv, *xa_wo, *rel_bias;
    unsigned char* ws; unsigned char* dout;
};
__device__ __forceinline__ float wave_sum(float v) {
#pragma unroll
    for (int o = 1; o < 64; o <<= 1) v += __shfl_xor(v, o);
    return v;
}

__device__ __forceinline__ void tr_item(const float* W, int ldw, int c0, half_t* dst, int K, int r0, int k0, float scale, LAS float* scr, int lane) {
#pragma unroll 8
    for (int i = 0; i < 32; ++i) { const int kk = 2 * i + (lane >> 5); scr[kk * 33 + (lane & 31)] = W[(size_t)(k0 + kk) * ldw + c0 + (lane & 31)]; }
    LDS_WAIT(); CFENCE();
    const int c = lane & 7;
#pragma unroll
    for (int j = 0; j < 4; ++j) { const int n = (lane >> 3) + 8 * j; const LAS float* s = scr + (8 * c) * 33 + n;
        *(h8*)(dst + (size_t)(r0 + n) * K + k0 + 8 * c) = pack8(s[0] * scale, s[33] * scale, s[66] * scale, s[99] * scale, s[132] * scale, s[165] * scale, s[198] * scale, s[231] * scale); }
    LDS_WAIT(); CFENCE();
}
__device__ __forceinline__ void mix_src(int nb, int& c0, float& scale) {
    const int r = nb * 32; scale = 1.f;
    if (r < C_QS) { c0 = O_IQ + (r - C_IQ); }
    else if (r < C_KS) { c0 = O_QS + (r - C_QS); scale = 0.125f * LOG2E; }
    else if (r < C_VS) { c0 = O_KS + (r - C_KS); }
    else if (r < C_CB) { c0 = O_VS + (r - C_VS); }
    else if (r < C_CC) { c0 = O_CB + (r - C_CB); }
    else if (r < C_CH) { c0 = O_CC + (r - C_CC); }
    else if (r < C_G) { c0 = O_CH + (r - C_CH); }
    else if (r < C_CKV) { c0 = O_GA + (r - C_G); }
    else if (r < C_IK) { c0 = O_CKV + (r - C_CKV); }
    else { c0 = O_IK + (r - C_IK); }
}
__device__ __forceinline__ void p_prep(Frame& F, int l) {
    LAS float* scr = (LAS float*)(F.lds + F.wave * 16384);
    const int gw = F.vcu * NWAVES + F.wave, NGW = F.G * NWAVES, lane = F.lane;
    unsigned char* wl = F.ws + WS_WL + (size_t)l * WL_STRIDE;
    half_t* WFIN = (half_t*)(wl + WL_WFIN); half_t* WFOUT = (half_t*)(wl + WL_WFOUT); half_t* WMIX = (half_t*)(wl + WL_WMIX);
    half_t* WBRA = (half_t*)(wl + WL_WBRA); half_t* WBRB = (half_t*)(wl + WL_WBRB); half_t* WBRC = (half_t*)(wl + WL_WBRC);
    half_t* WMO = (half_t*)(wl + WL_WMO); half_t* WXQ = (half_t*)(wl + WL_WXQ); half_t* WXKV = (half_t*)(wl + WL_WXKV); half_t* WXO = (half_t*)(wl + WL_WXO);
    const float* w_in_l = F.w_mix_in + (size_t)l * D * PT;
    constexpr int I_FIN = 176 * 16, I_FOUT = 32 * 44, I_MIX = 214 * 16, I_BR = 32 * 8, I_MO = 32 * 16, I_XQ = 16 * 16, I_XKV = 32 * 16, I_XO = 32 * 8;
    constexpr int NITEMS = 2 * I_FIN + 2 * I_FOUT + I_MIX + 2 * I_BR + I_MO + I_XQ + I_XKV + I_XO;
    for (int it = gw; it < NITEMS; it += NGW) {
        int r = it;
        if (r < 2 * I_FIN) { const int which = r / I_FIN; r -= which * I_FIN; const int nb = r / 16, kb = r % 16, pn = nb >> 3, w8 = nb & 7;
            const int c0 = (w8 < 4) ? (128 * pn + 32 * w8) : (DFF + 128 * pn + 32 * (w8 - 4));
            tr_item(F.ffn_w_in + (size_t)(l * 2 + which) * D * 2 * DFF, 2 * DFF, c0, WFIN + (size_t)which * 5632 * 1024, 1024, nb * 32, kb * 64, 1.f, scr, lane); continue; }
        r -= 2 * I_FIN;
        if (r < 2 * I_FOUT) { const int which = r / I_FOUT; r -= which * I_FOUT; const int nb = r / 44, kb = r % 44;
            tr_item(F.ffn_w_out + (size_t)(l * 2 + which) * DFF * D, D, nb * 32, WFOUT + (size_t)which * 1024 * DFF, DFF, nb * 32, kb * 64, 1.f, scr, lane); continue; }
        r -= 2 * I_FOUT;
        if (r < I_MIX) { const int nb = 32 + r / 16, kb = r % 16; int c0; float sc; mix_src(nb, c0, sc);
            tr_item(w_in_l, PT, c0, WMIX, 1024, nb * 32, kb * 64, sc, scr, lane); continue; }
        r -= I_MIX;
        if (r < 2 * I_BR) { const int which = r / I_BR; r -= which * I_BR; const int nb = r / 8, kb = r % 8;
            tr_item(F.w_branch + (size_t)(l * 3 + 1 + which) * 512 * D, D, nb * 32, which ? WBRC : WBRB, 512, nb * 32, kb * 64, 1.f, scr, lane); continue; }
        r -= 2 * I_BR;
        if (r < I_MO) { const int nb = r / 16, kb = r % 16; tr_item(F.w_mix_out + (size_t)l * D * D, D, nb * 32, WMO, 1024, nb * 32, kb * 64, 1.f, scr, lane); continue; }
        r -= I_MO;
        if (r < I_XQ) { const int nb = r / 16, kb = r % 16; tr_item(F.xa_wq + (size_t)l * D * 512, 512, nb * 32, WXQ, 1024, nb * 32, kb * 64, 0.08838834764831845f * LOG2E, scr, lane); continue; }
        r -= I_XQ;
        if (r < I_XKV) { const int nb = r / 16, kb = r % 16; tr_item(F.xa_wkv + (size_t)l * D * 1024, 1024, nb * 32, WXKV, 1024, nb * 32, kb * 64, 1.f, scr, lane); continue; }
        r -= I_XKV;
        { const int nb = r / 8, kb = r % 8; tr_item(F.xa_wo + (size_t)l * 512 * D, D, nb * 32, WXO, 512, nb * 32, kb * 64, 1.f, scr, lane); }
    }
    for (int tk = gw; tk < 8 * 2 * 32; tk += NGW) {
        const int h = tk >> 6, chalf = (tk >> 5) & 1, kb = tk & 31, c = chalf * 64 + lane;
        float wk[64];
#pragma unroll
        for (int d = 0; d < 64; ++d) wk[d] = F.w_uk[((size_t)(l * 8 + h) * 64 + d) * 128 + c] * (0.125f * LOG2E);
#pragma unroll 1
        for (int kk = 0; kk < 32; ++kk) { const float* wr_ = w_in_l + (size_t)(kb * 32 + kk) * PT + O_QA + h * 64; float a0 = 0.f, a1 = 0.f;
#pragma unroll
            for (int d = 0; d < 64; d += 2) { a0 += wr_[d] * wk[d]; a1 += wr_[d + 1] * wk[d + 1]; }
            WMIX[(size_t)(h * 128 + c) * 1024 + kb * 32 + kk] = (half_t)(a0 + a1); }
    }
    for (int tk = gw; tk < 8 * 16 * 4; tk += NGW) {
        const int h = tk >> 6, nblk = (tk >> 2) & 15, cq = tk & 3, n = nblk * 64 + lane;
        const float* wb0 = F.w_branch + (size_t)(l * 3) * 512 * D;
        float wb[64];
#pragma unroll
        for (int d = 0; d < 64; ++d) wb[d] = wb0[(size_t)(h * 64 + d) * D + n];
#pragma unroll 1
        for (int cc = 0; cc < 32; ++cc) { const float* uv = F.w_uv + ((size_t)(l * 8 + h) * 128 + cq * 32 + cc) * 64; float a0 = 0.f, a1 = 0.f;
#pragma unroll
            for (int d = 0; d < 64; d += 2) { a0 += uv[d] * wb[d]; a1 += uv[d + 1] * wb[d + 1]; }
            WBRA[(size_t)n * 1024 + h * 128 + cq * 32 + cc] = (half_t)(a0 + a1); }
    }
    for (int i = gw * 64 + lane; i < 64 * 1024; i += NGW * 64) { const int rr = i >> 10, k = i & 1023;
        WMIX[(size_t)(C_IW + rr) * 1024 + k] = rr < 8 ? (half_t)(w_in_l[(size_t)k * PT + O_IW + rr] * (0.35355339059327373f * 0.125f)) : (half_t)0.f; }
    { float* bias = (float*)(wl + WL_BIAS);
      for (int i = gw * 64 + lane; i < NMIX; i += NGW * 64) bias[i] = (i >= C_G && i < C_CKV) ? F.b_gate[(size_t)l * 3 * D + (i - C_G)] : 0.f; }
    if (l == 0) { half_t* MEMH = (half_t*)(F.ws + WS_MEMH); half_t* MEMP = (half_t*)(F.ws + WS_MEMP);
      for (int i = gw * 64 + lane; i < 2048 * 128; i += NGW * 64) { const int row = i >> 7, c8 = (i & 127) * 8;
          const f32x4 a = *(const f32x4*)(F.mem + (size_t)row * 1024 + c8), b = *(const f32x4*)(F.mem + (size_t)row * 1024 + c8 + 4);
          const h8 v = pack8(a[0], a[1], a[2], a[3], b[0], b[1], b[2], b[3]);
          *(h8*)(MEMH + (size_t)row * 1024 + c8) = v;
          const int prow = (row & ~12) | ((row & 4) << 1) | ((row & 8) >> 1);
          *(h8*)(MEMP + (size_t)prow * 1024 + c8) = v; } }
    if (l == 0) {
        float* sm = (float*)(F.ws + WS_SMALL); const int gt = gw * 64 + lane, NT = NGW * 64;
        for (int i = gt; i < DEPTH * 4 * D; i += NT) { sm[SM_LNG / 4 + i] = F.ln_g[i]; sm[SM_LNB / 4 + i] = F.ln_b[i]; }
        for (int i = gt; i < DEPTH * 128; i += NT) sm[SM_KVG / 4 + i] = F.kv_g[i];
        for (int i = gt; i < DEPTH * 3 * 512; i += NT) sm[SM_CONV / 4 + i] = F.conv_w[i];
        for (int i = gt; i < 256; i += NT) sm[SM_RB / 4 + i] = F.rel_bias[i] * LOG2E;
    }
}
__device__ __forceinline__ void p_x_to_half(Frame& F) {
    half_t* X = (half_t*)(F.ws + WS_X); const int gt = (F.vcu * NWAVES + F.wave) * 64 + F.lane, NT = F.G * NWAVES * 64;
    for (size_t i = gt; i < (size_t)M * D / 8; i += NT) { const f32x4 a = *(const f32x4*)(F.x_in + i * 8), b = *(const f32x4*)(F.x_in + i * 8 + 4);
        *(h8*)(X + i * 8) = pack8(a[0], a[1], a[2], a[3], b[0], b[1], b[2], b[3]); }
}
__device__ __forceinline__ void p_ln(Frame& F, const half_t* V, const float* g, const float* b, float* outf) {
    half_t* X = (half_t*)(F.ws + WS_X); const int gw = F.vcu * NWAVES + F.wave, NGW = F.G * NWAVES, lane = F.lane;
    f32x4 gv[4], bv[4];
#pragma unroll
    for (int j = 0; j < 4; ++j) { gv[j] = *(const f32x4*)(g + 256 * j + 4 * lane); bv[j] = *(const f32x4*)(b + 256 * j + 4 * lane); }
    for (int m = gw; m < M; m += NGW) {
        const half_t* vr = V + (size_t)m * D; f32x4 v[4]; float s = 0.f;
#pragma unroll
        for (int j = 0; j < 4; ++j) { const h4 hv = *(const h4*)(vr + 256 * j + 4 * lane); v[j] = (f32x4){(float)hv[0], (float)hv[1], (float)hv[2], (float)hv[3]}; s += (v[j][0] + v[j][1]) + (v[j][2] + v[j][3]); }
        const float mean = wave_sum(s) * (1.f / D); float s2 = 0.f;
#pragma unroll
        for (int j = 0; j < 4; ++j) { v[j] = v[j] - mean; s2 += (v[j][0] * v[j][0] + v[j][1] * v[j][1]) + (v[j][2] * v[j][2] + v[j][3] * v[j][3]); }
        const float rstd = 1.f / sqrtf(wave_sum(s2) * (1.f / D) + LN_EPS);
#pragma unroll
        for (int j = 0; j < 4; ++j) { const f32x4 o = v[j] * rstd * gv[j] + bv[j];
            *(h4*)(X + (size_t)m * D + 256 * j + 4 * lane) = pack4(o[0], o[1], o[2], o[3]);
            if (outf) *(f32x4*)(outf + (size_t)m * D + 256 * j + 4 * lane) = o; }
    }
}
__device__ __forceinline__ h8 tr_pair(const LAS unsigned char* p0, const LAS unsigned char* p1) {
    const s4v a = __builtin_amdgcn_ds_read_tr16_b64_v4i16((LAS s4v*)p0);
    const s4v b = __builtin_amdgcn_ds_read_tr16_b64_v4i16((LAS s4v*)p1);
    const s8v r = __builtin_shufflevector(a, b, 0, 1, 2, 3, 4, 5, 6, 7);
    return __builtin_bit_cast(h8, r);
}
__device__ __forceinline__ int crow(int i, int h) { return (i & 3) + 8 * (i >> 2) + 4 * h; }

constexpr int SB_VPITCH = 144;
__device__ __forceinline__ void sb_job(Frame& F, const half_t* MIX, half_t* YB, int job) {
    const int lane = opaque_lane(), r = lane & 31, hh = lane >> 5;
    const int blk = job & 127, h = (job >> 7) & 7, b = job >> 10;
    const size_t R0 = (size_t)b * S; const int t0 = blk * 32;
    LAS unsigned char* vb = F.lds + F.wave * 8192;
    h8 qf[4];
#pragma unroll
    for (int st = 0; st < 4; ++st) qf[st] = *(const h8*)(MIX + (R0 + t0 + r) * NMIX + C_QS + h * 64 + 16 * st + 8 * hh);
    f32x16 oacc[2];
#pragma unroll
    for (int c = 0; c < 2; ++c)
#pragma unroll
        for (int i = 0; i < 16; ++i) oacc[c][i] = 0.f;
    float Rsum = 0.f;
    h8 kfn[4], vvn[4];
    { const size_t kr = R0 + (size_t)blk * 32;
#pragma unroll
      for (int st = 0; st < 4; ++st) kfn[st] = *(const h8*)(MIX + (kr + r) * NMIX + C_KS + h * 64 + 16 * st + 8 * hh);
#pragma unroll
      for (int i = 0; i < 4; ++i) vvn[i] = *(const h8*)(MIX + (kr + 8 * i + (lane >> 3)) * NMIX + C_VS + h * 64 + 8 * (lane & 7)); }
    for (int kt = blk; kt >= 0; --kt) {
        h8 kf[4], vv[4];
#pragma unroll
        for (int st = 0; st < 4; ++st) { kf[st] = kfn[st]; vv[st] = vvn[st]; }
        if (kt > 0) {
            const size_t kr = R0 + (size_t)(kt - 1) * 32;
#pragma unroll
            for (int st = 0; st < 4; ++st) kfn[st] = *(const h8*)(MIX + (kr + r) * NMIX + C_KS + h * 64 + 16 * st + 8 * hh);
#pragma unroll
            for (int i = 0; i < 4; ++i) vvn[i] = *(const h8*)(MIX + (kr + 8 * i + (lane >> 3)) * NMIX + C_VS + h * 64 + 8 * (lane & 7));
        }
        f32x16 sacc;
#pragma unroll
        for (int i = 0; i < 16; ++i) sacc[i] = 0.f;
#pragma unroll
        for (int st = 0; st < 4; ++st) sacc = __builtin_amdgcn_mfma_f32_32x32x16_f16(kf[st], qf[st], sacc, 0, 0, 0);
        CFENCE();
#pragma unroll
        for (int i = 0; i < 4; ++i) *(LAS h8*)(vb + (8 * i + (lane >> 3)) * SB_VPITCH + 16 * (lane & 7)) = vv[i];
        CFENCE();
        if (kt == blk) {
            int rr = r; asm volatile("" : "+v"(rr));
#pragma unroll
            for (int i = 0; i < 16; ++i) sacc[i] = (crow(i, hh) < rr) ? sacc[i] : -1e30f;
        }
        float L[16], zl[16];
#pragma unroll
        for (int i = 0; i < 16; ++i) {
            const float z = sacc[i]; const float sp = fmaxf(z, 0.f) + lg2(1.f + ex2(-fabsf(z)));
            L[i] = -sp; zl[i] = z - sp;
        }
        float bs[4], pbs[4];
#pragma unroll
        for (int q = 0; q < 4; ++q) { bs[q] = (L[4 * q] + L[4 * q + 1]) + (L[4 * q + 2] + L[4 * q + 3]); pbs[q] = __shfl_xor(bs[q], 32); }
        float after[4]; after[3] = 0.f; after[2] = bs[3] + pbs[3]; after[1] = after[2] + (bs[2] + pbs[2]); after[0] = after[1] + (bs[1] + pbs[1]);
        const float tile_total = after[0] + (bs[0] + pbs[0]);
        float p[16];
#pragma unroll
        for (int q = 0; q < 4; ++q) {
            const float base = Rsum + after[q] + (hh == 0 ? pbs[q] : 0.f);
            const float s3 = base, s2 = s3 + L[4 * q + 3], s1 = s2 + L[4 * q + 2], s0 = s1 + L[4 * q + 1];
            p[4 * q + 3] = ex2(zl[4 * q + 3] + s3); p[4 * q + 2] = ex2(zl[4 * q + 2] + s2); p[4 * q + 1] = ex2(zl[4 * q + 1] + s1); p[4 * q] = ex2(zl[4 * q] + s0);
        }
        Rsum += tile_total;
        const h8 pf0 = pack8(p[0], p[1], p[2], p[3], p[4], p[5], p[6], p[7]), pf1 = pack8(p[8], p[9], p[10], p[11], p[12], p[13], p[14], p[15]);
        const int q4 = (lane & 15) >> 2, pp = lane & 3, blk16 = (lane >> 4) & 1;
#pragma unroll
        for (int c = 0; c < 2; ++c)
#pragma unroll
            for (int s2 = 0; s2 < 2; ++s2) {
                const LAS unsigned char* a0 = vb + (16 * s2 + 4 * hh + q4) * SB_VPITCH + (32 * c + 16 * blk16) * 2 + 8 * pp;
                const h8 vf = tr_pair(a0, a0 + 8 * SB_VPITCH);
                oacc[c] = __builtin_amdgcn_mfma_f32_32x32x16_f16(vf, s2 ? pf1 : pf0, oacc[c], 0, 0, 0);
            }
        CFENCE();
        if (__ballot(Rsum > -160.f) == 0ull) break;
    }
    half_t* orow = YB + (R0 + t0 + r) * 512 + h * 64;
#pragma unroll
    for (int c = 0; c < 2; ++c)
#pragma unroll
        for (int q = 0; q < 4; ++q) *(h4*)(orow + 32 * c + 8 * q + 4 * hh) = pack4(oacc[c][4 * q], oacc[c][4 * q + 1], oacc[c][4 * q + 2], oacc[c][4 * q + 3]);
}

__device__ __forceinline__ void rms_job(Frame& F, const half_t* MIX, half_t* CKVN, const float* kvg, int job) {
    const int lane = opaque_lane(), row = job * 4 + (lane >> 4), c8 = (lane & 15) * 8;
    const h8 v = *(const h8*)(MIX + (size_t)row * NMIX + C_CKV + c8); float f[8], s = 0.f;
#pragma unroll
    for (int j = 0; j < 8; ++j) { f[j] = (float)v[j]; s += f[j] * f[j]; }
    s += __shfl_xor(s, 1); s += __shfl_xor(s, 2); s += __shfl_xor(s, 4); s += __shfl_xor(s, 8);
    const float rs = 1.f / sqrtf(s * (1.f / 128.f) + LN_EPS);
    const f32x4 g0 = *(const f32x4*)(kvg + c8), g1 = *(const f32x4*)(kvg + c8 + 4);
    *(h8*)(CKVN + (size_t)row * 128 + c8) = pack8(f[0] * rs * g0[0], f[1] * rs * g0[1], f[2] * rs * g0[2], f[3] * rs * g0[3], f[4] * rs * g1[0], f[5] * rs * g1[1], f[6] * rs * g1[2], f[7] * rs * g1[3]);
}
__device__ __forceinline__ void conv_job(Frame& F, const half_t* MIX, half_t* YC, const float* cw, int job) {
    const int lane = opaque_lane(), c8 = lane * 8, row0 = job * 8, tb = row0 & (S - 1);
    h8 cc[10], chv[10], cb[8];
#pragma unroll
    for (int i = 0; i < 10; ++i) { const int rr = (tb == 0 && i < 2) ? row0 : row0 - 2 + i;
        cc[i] = *(const h8*)(MIX + (size_t)rr * NMIX + C_CC + c8); chv[i] = *(const h8*)(MIX + (size_t)rr * NMIX + C_CH + c8); }
#pragma unroll
    for (int i = 0; i < 8; ++i) cb[i] = *(const h8*)(MIX + (size_t)(row0 + i) * NMIX + C_CB + c8);
    float w0[8], w1[8], w2[8];
#pragma unroll
    for (int j = 0; j < 8; ++j) { w0[j] = cw[c8 + j]; w1[j] = cw[512 + c8 + j]; w2[j] = cw[1024 + c8 + j]; }
    float z2[8], z1[8];
#pragma unroll
    for (int j = 0; j < 8; ++j) { z2[j] = tb == 0 ? 0.f : (float)cc[0][j] * (float)chv[0][j]; z1[j] = tb == 0 ? 0.f : (float)cc[1][j] * (float)chv[1][j]; }
#pragma unroll
    for (int i = 0; i < 8; ++i) { float o[8];
#pragma unroll
        for (int j = 0; j < 8; ++j) { const float z0 = (float)cc[i + 2][j] * (float)chv[i + 2][j]; o[j] = (float)cb[i][j] * (w0[j] * z2[j] + w1[j] * z1[j] + w2[j] * z0); z2[j] = z1[j]; z1[j] = z0; }
        *(h8*)(YC + (size_t)(row0 + i) * 512 + c8) = pack8(o[0], o[1], o[2], o[3], o[4], o[5], o[6], o[7]); }
}

__device__ __forceinline__ unsigned f2ord(float f) { const unsigned u = __float_as_uint(f); return (u & 0x80000000u) ? ~u : (u | 0x80000000u); }
template <int NR>
__device__ __forceinline__ void topk_select(const float* sc, int t, LAS unsigned short* out, int lane) {
    unsigned u[NR];
#pragma unroll
    for (int j = 0; j < NR; ++j) u[j] = ((const unsigned*)sc)[j * 64 + lane];
    CFENCE();
#pragma unroll
    for (int j = 0; j < NR; ++j) { const int s = j * 64 + lane; const unsigned v = u[j]; u[j] = s <= t ? ((v & 0x80000000u) ? ~v : (v | 0x80000000u)) : 0x007FFFFFu; }
    unsigned T = 0;
    for (int bit = 31; bit >= 0; --bit) {
        const unsigned cand = T | (1u << bit); int c = 0;
#pragma unroll
        for (int j = 0; j < NR; ++j) { c += __builtin_popcountll(__ballot(u[j] >= cand));
            if ((j & 7) == 7) __builtin_amdgcn_sched_barrier(0); }
        if (c >= 256) { T = cand; if (c == 256) break; }
    }
    int cgt = 0;
#pragma unroll
    for (int j = 0; j < NR; ++j) { cgt += __builtin_popcountll(__ballot(u[j] > T)); if ((j & 7) == 7) __builtin_amdgcn_sched_barrier(0); }
    int need = 256 - cgt, base = 0;
    const unsigned long long below = (1ull << lane) - 1ull;
#pragma unroll
    for (int j = 0; j < NR; ++j) {
        const unsigned long long mgt = __ballot(u[j] > T), meq = __ballot(u[j] == T);
        const int eqrank = __builtin_popcountll(meq & below); const bool take_eq = (u[j] == T) && (eqrank < need);
        const unsigned long long msel = mgt | __ballot(take_eq);
        const int neq = __builtin_popcountll(meq); need -= neq < need ? neq : need;
        if ((msel >> lane) & 1ull) out[base + __builtin_popcountll(msel & below)] = (unsigned short)(j * 64 + lane);
        base += __builtin_popcountll(msel);
    }
}
__device__ __forceinline__ void idx_job(Frame& F, const half_t* MIX, unsigned short* IDX, float* SCR, int job) {
    const int lane = opaque_lane(), wave = F.wave, r = lane & 31, hk = lane >> 5;
    const int b = job >> 8, qt = job & 255, t0 = qt * 16;
    const size_t R0 = (size_t)b * S;
    LAS float* wl = (LAS float*)(F.lds + 65536);
    LAS unsigned short* ol = (LAS unsigned short*)(F.lds + 66048 + wave * 512);
    float* sc = SCR + (size_t)blockIdx.x * (16 * 4096);
    if (t0 + 15 < 256) {
#pragma unroll
        for (int qq = 0; qq < 2; ++qq) { const int t = t0 + 2 * wave + qq; unsigned short k4[4];
#pragma unroll
            for (int j = 0; j < 4; ++j) { const int s = 4 * lane + j; k4[j] = s <= t ? (unsigned short)s : (unsigned short)0xFFFF; }
            *(u32x2*)(IDX + (R0 + t) * 256 + 4 * lane) = (u32x2){(unsigned)k4[0] | ((unsigned)k4[1] << 16), (unsigned)k4[2] | ((unsigned)k4[3] << 16)}; }
        return;
    }
    const int tidj = wave * 64 + lane;
    if (tidj < 128) { const int q = tidj >> 3, hd = tidj & 7; wl[tidj] = (float)MIX[(R0 + t0 + q) * NMIX + C_IW + hd]; }
    const int blk = r >> 2, e = r & 3, tq = 2 * (blk & 1) + (blk >> 2), hd = 4 * ((blk >> 1) & 1) + e;
    const int Tb = (wave >> 2) * 2;
    h8 af[2][4];
#pragma unroll
    for (int T = 0; T < 2; ++T)
#pragma unroll
        for (int st = 0; st < 4; ++st) af[T][st] = *(const h8*)(MIX + (R0 + t0 + 4 * (Tb + T) + tq) * NMIX + C_IQ + hd * 64 + 16 * st + 8 * hk);
    __syncthreads();
    const int nkt = (t0 + 16 + 31) >> 5;
#ifndef REP_ST1
#define REP_ST1 1
#endif
#ifndef REP_ST2
#define REP_ST2 1
#endif
    _Pragma("nounroll") for (int rp1 = 0; rp1 < REP_ST1; ++rp1) {
    h8 bfn[4];
    if ((wave & 3) < nkt) {
#pragma unroll
        for (int st = 0; st < 4; ++st) bfn[st] = *(const h8*)(MIX + (R0 + (size_t)(wave & 3) * 32 + r) * NMIX + C_IK + 16 * st + 8 * hk); }
    for (int kt = (wave & 3); kt < nkt; kt += 4) {
        h8 bf[4];
#pragma unroll
        for (int st = 0; st < 4; ++st) bf[st] = bfn[st];
        if (kt + 4 < nkt) {
#pragma unroll
            for (int st = 0; st < 4; ++st) bfn[st] = *(const h8*)(MIX + (R0 + (size_t)(kt + 4) * 32 + r) * NMIX + C_IK + 16 * st + 8 * hk); }
#pragma unroll
        for (int T = 0; T < 2; ++T) {
            f32x16 acc;
#pragma unroll
            for (int i = 0; i < 16; ++i) acc[i] = 0.f;
#pragma unroll
            for (int st = 0; st < 4; ++st) acc = __builtin_amdgcn_mfma_f32_32x32x16_f16(af[T][st], bf[st], acc, 0, 0, 0);
#pragma unroll
            for (int q2 = 0; q2 < 2; ++q2) { const int ql = 4 * (Tb + T) + 2 * hk + q2;
                const f32x4 w0 = *(const LAS f32x4*)(wl + ql * 8), w1 = *(const LAS f32x4*)(wl + ql * 8 + 4); float sco = 0.f;
#pragma unroll
                for (int j = 0; j < 4; ++j) { sco += w0[j] * fmaxf(acc[q2 * 8 + j], 0.f); sco += w1[j] * fmaxf(acc[q2 * 8 + 4 + j], 0.f); }
                sc[ql * 4096 + kt * 32 + r] = sco; }
            __builtin_amdgcn_sched_barrier(0);
        }
    }
    }
    VM_WAIT(); __syncthreads();
#pragma unroll 1
    for (int qq = 0; qq < 2 * REP_ST2; ++qq) {
        const int ql = 2 * wave + (qq & 1), t = t0 + ql; const float* srow = sc + ql * 4096;
#ifdef TOPK_ONE
        topk_select<64>(srow, t, ol, lane);
#else
        if (t0 + 16 <= 1024) topk_select<16>(srow, t, ol, lane);
        else if (t0 + 16 <= 2048) topk_select<32>(srow, t, ol, lane);
        else if (t0 + 16 <= 3072) topk_select<48>(srow, t, ol, lane);
        else topk_select<64>(srow, t, ol, lane);
#endif
        LDS_WAIT(); CFENCE();
        *(u32x2*)(IDX + (R0 + t) * 256 + 4 * lane) = *(const LAS u32x2*)(ol + 4 * lane);
        LDS_WAIT(); CFENCE();
    }
    VM_WAIT(); __syncthreads();
}
constexpr int GA_PITCH = 272;
constexpr int GA_WAVE_BYTES = 10240;
constexpr int GA_TAB_OFF = 8 * GA_WAVE_BYTES;
__device__ __forceinline__ void ga_tables(Frame& F) {
    LAS float* rb = (LAS float*)(F.lds + GA_TAB_OFF); LAS unsigned char* t5 = F.lds + GA_TAB_OFF + 1024;
    if (F.tid < 256) rb[F.tid] = ((const float*)(F.ws + WS_SMALL + SM_RB))[F.tid];
    if (F.tid < 128) t5[F.tid] = T5.v[F.tid];
    __syncthreads();
}
__device__ __forceinline__ void ga_job(Frame& F, const half_t* MIX, const half_t* CKVN, const unsigned short* IDX, half_t* YA, int row) {
    const int lane = opaque_lane(), n16 = lane & 15, g = lane >> 4, t = row & (S - 1);
    const size_t R0 = (size_t)(row - t);
    LAS unsigned char* kvb = F.lds + F.wave * GA_WAVE_BYTES;
    LAS unsigned short* il = (LAS unsigned short*)(kvb + 8704);
    LAS float* al = (LAS float*)(kvb + 8704 + 512);
    const LAS float* rb = (const LAS float*)(F.lds + GA_TAB_OFF); const LAS unsigned char* t5 = F.lds + GA_TAB_OFF + 1024;
    *(LAS u32x2*)(il + 4 * lane) = *(const u32x2*)(IDX + (size_t)row * 256 + 4 * lane);
    h8 qf[4];
#pragma unroll
    for (int st = 0; st < 4; ++st) { h8 z;
#pragma unroll
        for (int j = 0; j < 8; ++j) z[j] = (half_t)0.f;
        qf[st] = n16 < 8 ? *(const h8*)(MIX + (size_t)row * NMIX + C_QL + n16 * 128 + 32 * st + 8 * g) : z; }
    f32x4 oacc[8];
#pragma unroll
    for (int nt = 0; nt < 8; ++nt) oacc[nt] = (f32x4){0.f, 0.f, 0.f, 0.f};
    float mrun = -1e30f, lsum = 0.f;
    LDS_WAIT(); CFENCE();
    h8 gr[8];
#pragma unroll
    for (int i = 0; i < 8; ++i) { unsigned key = il[4 * i + g]; key = key <= (unsigned)t ? key : 0u; gr[i] = *(const h8*)(CKVN + (R0 + key) * 128 + 8 * n16); }
#pragma unroll 1
    for (int ch = 0; ch < 8; ++ch) {
        CFENCE();
#pragma unroll
        for (int i = 0; i < 8; ++i) *(LAS h8*)(kvb + (4 * i + g) * GA_PITCH + 16 * n16) = gr[i];
        CFENCE();
        if (ch < 7) {
#pragma unroll
            for (int i = 0; i < 8; ++i) { unsigned key = il[32 * (ch + 1) + 4 * i + g]; key = key <= (unsigned)t ? key : 0u; gr[i] = *(const h8*)(CKVN + (R0 + key) * 128 + 8 * n16); }
        }
        f32x4 lacc[2];
#pragma unroll
        for (int u = 0; u < 2; ++u) { lacc[u] = (f32x4){0.f, 0.f, 0.f, 0.f};
#pragma unroll
            for (int st = 0; st < 4; ++st) { const h8 a = *(const LAS h8*)(kvb + (16 * u + n16) * GA_PITCH + (32 * st + 8 * g) * 2);
                lacc[u] = __builtin_amdgcn_mfma_f32_16x16x32_f16(a, qf[st], lacc[u], 0, 0, 0); } }
        float lg[8]; float cm = -1e30f;
#pragma unroll
        for (int u = 0; u < 2; ++u) { const u32x2 kk = *(const LAS u32x2*)(il + 32 * ch + 16 * u + 4 * g);
#pragma unroll
            for (int r = 0; r < 4; ++r) { const unsigned key = (r < 2 ? (kk[0] >> (16 * r)) : (kk[1] >> (16 * (r - 2)))) & 0xFFFFu;
                const bool ok = key <= (unsigned)t; const int dist = ok ? (t - (int)key) : 0; const int bucket = dist < 128 ? (int)t5[dist] : 31;
                const float v = ok ? lacc[u][r] + rb[bucket * 8 + (n16 & 7)] : -1e30f; lg[4 * u + r] = v; cm = fmaxf(cm, v); } }
        cm = fmaxf(cm, __shfl_xor(cm, 16)); cm = fmaxf(cm, __shfl_xor(cm, 32));
        const float mnew = fmaxf(mrun, cm), alpha = ex2(mrun - mnew); mrun = mnew;
        float p[8], ps = 0.f;
#pragma unroll
        for (int j = 0; j < 8; ++j) { p[j] = ex2(lg[j] - mnew); ps += p[j]; }
        lsum = lsum * alpha + ps;
        const h8 pf = pack8(p[0], p[1], p[2], p[3], p[4], p[5], p[6], p[7]);
        if (g == 0) al[n16] = alpha;
        LDS_WAIT(); CFENCE();
        const f32x4 av = *(const LAS f32x4*)(al + 4 * g);
#pragma unroll
        for (int nt = 0; nt < 8; ++nt) {
            oacc[nt] = oacc[nt] * av;
            const LAS unsigned char* a0 = kvb + (4 * g + ((lane >> 2) & 3)) * GA_PITCH + 32 * nt + 8 * (lane & 3);
            const h8 vf = tr_pair(a0, a0 + 16 * GA_PITCH);
            oacc[nt] = __builtin_amdgcn_mfma_f32_16x16x32_f16(pf, vf, oacc[nt], 0, 0, 0);
        }
        CFENCE();
    }
    lsum += __shfl_xor(lsum, 16); lsum += __shfl_xor(lsum, 32);
    if (g == 0) al[n16] = 1.f / lsum;
    LDS_WAIT(); CFENCE();
    const f32x4 iv = *(const LAS f32x4*)(al + 4 * g);
    if (g < 2) {
#pragma unroll
        for (int nt = 0; nt < 8; ++nt)
#pragma unroll
            for (int r = 0; r < 4; ++r) *(LAS half_t*)(kvb + ((4 * g + r) * 128 + 16 * nt + n16) * 2) = (half_t)(oacc[nt][r] * iv[r]);
    }
    LDS_WAIT(); CFENCE();
#pragma unroll
    for (int i = 0; i < 2; ++i) *(h8*)(YA + (size_t)row * 1024 + (i * 64 + lane) * 8) = *(const LAS h8*)(kvb + (i * 64 + lane) * 16);
    LDS_WAIT(); CFENCE();
}

__device__ __forceinline__ void xa_job(Frame& F, const half_t* XQ, const half_t* XK, const half_t* XVT, half_t* XO, int job) {
    const int lane = opaque_lane(), r = lane & 31, hk = lane >> 5;
    const int qb = job & 127, hd = (job >> 7) & 3, b = job >> 9;
    const size_t qrow = (size_t)b * S + qb * 32 + r;
    h8 qf[8];
#pragma unroll
    for (int st = 0; st < 8; ++st) qf[st] = *(const h8*)(XQ + qrow * 512 + hd * 128 + 16 * st + 8 * hk);
    f32x16 oacc[4];
#pragma unroll
    for (int c = 0; c < 4; ++c)
#pragma unroll
        for (int i = 0; i < 16; ++i) oacc[c][i] = 0.f;
    float mrun = -1e30f, lsum = 0.f;
#pragma unroll 1
    for (int kt = 0; kt < 8; ++kt) {
        f32x16 sacc;
#pragma unroll
        for (int i = 0; i < 16; ++i) sacc[i] = 0.f;
#pragma unroll
        for (int st = 0; st < 8; ++st) { const h8 kf = *(const h8*)(XK + ((size_t)b * 256 + kt * 32 + r) * 512 + hd * 128 + 16 * st + 8 * hk);
            sacc = __builtin_amdgcn_mfma_f32_32x32x16_f16(kf, qf[st], sacc, 0, 0, 0); }
        float cm = sacc[0];
#pragma unroll
        for (int i = 1; i < 16; ++i) cm = fmaxf(cm, sacc[i]);
        cm = fmaxf(cm, __shfl_xor(cm, 32));
        const float mnew = fmaxf(mrun, cm), alpha = ex2(mrun - mnew); mrun = mnew;
        float p[16], ps = 0.f;
#pragma unroll
        for (int i = 0; i < 16; ++i) { p[i] = ex2(sacc[i] - mnew); ps += p[i]; }
        lsum = lsum * alpha + ps;
        const h8 pf0 = pack8(p[0], p[1], p[2], p[3], p[4], p[5], p[6], p[7]), pf1 = pack8(p[8], p[9], p[10], p[11], p[12], p[13], p[14], p[15]);
#pragma unroll
        for (int c = 0; c < 4; ++c) {
#pragma unroll
            for (int i = 0; i < 16; ++i) oacc[c][i] *= alpha;
#pragma unroll
            for (int s2 = 0; s2 < 2; ++s2) { const h8 vf = *(const h8*)(XVT + (size_t)(hd * 128 + 32 * c + r) * 2048 + b * 256 + kt * 32 + 16 * s2 + 8 * hk);
                oacc[c] = __builtin_amdgcn_mfma_f32_32x32x16_f16(vf, s2 ? pf1 : pf0, oacc[c], 0, 0, 0); }
        }
    }
    lsum += __shfl_xor(lsum, 32);
    const float inv = 1.f / lsum;
    half_t* orow = XO + qrow * 512 + hd * 128;
#pragma unroll
    for (int c = 0; c < 4; ++c)
#pragma unroll
        for (int q = 0; q < 4; ++q) *(h4*)(orow + 32 * c + 8 * q + 4 * hk) = pack4(oacc[c][4 * q] * inv, oacc[c][4 * q + 1] * inv, oacc[c][4 * q + 2] * inv, oacc[c][4 * q + 3] * inv);
}
#ifndef MK_N_LAUNCHES
#define MK_N_LAUNCHES 1
#endif
#ifndef REP_GEMM
#define REP_GEMM 1
#endif
#ifndef REP_M2
#define REP_M2 1
#endif
#ifndef REP_FIN
#define REP_FIN 1
#endif
#ifndef REP_IDX
#define REP_IDX 1
#endif
#ifndef REP_SB
#define REP_SB 1
#endif
#ifndef REP_M3
#define REP_M3 1
#endif
#ifndef REP_XA
#define REP_XA 1
#endif
#ifndef REP_MISC
#define REP_MISC 1
#endif
constexpr int NSLOT = 20, NPHASE = 1 + DEPTH * NSLOT;
struct Args { const float* in[18]; float* out; unsigned char* ws; int ph_lo, ph_hi; };
__global__ void __launch_bounds__(NWAVES * 64, 2) fwd(Args args) {
    extern __shared__ __attribute__((aligned(16))) unsigned char lds_raw[];
    Frame F;
    F.lds = (LAS unsigned char*)lds_raw;
    F.wave = __builtin_amdgcn_readfirstlane((int)threadIdx.x >> 6); F.lane = opaque_lane(); F.tid = F.wave * 64 + F.lane;
    F.G = gridDim.x; { const int bx = blockIdx.x; F.vcu = (F.G % 8 == 0) ? (bx % 8) * (F.G / 8) + bx / 8 : bx; }
    F.ws = args.ws; F.dout = (unsigned char*)args.out;
    unsigned char* const ws = args.ws;
    for (int u = F.tid; u < (LDS_BYTES - LDSCTL_OFF) / 4; u += NWAVES * 64) ((LAS unsigned*)(F.lds + LDSCTL_OFF))[u] = 0u;
    __syncthreads();
    const int lo = args.ph_lo, hi = args.ph_hi;
    XcdBarrier bar; bar.bar = (unsigned*)(ws + WS_CTL) + CW_BAR; bar.x = 0; bar.st = nullptr; bar.wave = F.wave;
    if (hi - lo > 1) bar = xcd_barrier_post((unsigned*)(ws + WS_CTL) + CW_BAR, (volatile LAS unsigned*)(F.lds + MISC_OFF) + 8, F.wave);
#define RUN(gp) ((gp) >= lo && (gp) < hi && ((F.lane = opaque_lane()), (F.tid = F.wave * 64 + F.lane), true))
#define SEAM(gp) do { if ((gp) >= lo && (gp) + 1 < hi) xcd_barrier(bar); } while (0)
#define REPL(n) _Pragma("nounroll") for (int rep = 0; rep < (n); ++rep)

    if (RUN(0)) REPL(REP_MISC) {
        F.x_in = args.in[0]; F.mem = args.in[1]; F.ln_g = args.in[2]; F.ln_b = args.in[3]; F.ffn_w_in = args.in[4]; F.ffn_w_out = args.in[5]; F.w_mix_in = args.in[6]; F.b_gate = args.in[7];
        F.kv_g = args.in[8]; F.w_uk = args.in[9]; F.w_uv = args.in[10]; F.conv_w = args.in[11]; F.w_branch = args.in[12]; F.w_mix_out = args.in[13]; F.xa_wq = args.in[14]; F.xa_wkv = args.in[15];
        F.xa_wo = args.in[16]; F.rel_bias = args.in[17];
        for (int l = 0; l < DEPTH; ++l) p_prep(F, l);
        p_x_to_half(F);
    }
    SEAM(0);

    half_t* const X = (half_t*)(ws + WS_X);
    half_t* const MEMH = (half_t*)(ws + WS_MEMH); half_t* const MEMP = (half_t*)(ws + WS_MEMP);
    half_t* const XK = (half_t*)(ws + WS_XK); half_t* const XVT = (half_t*)(ws + WS_XVT);
    half_t* const CKVN = (half_t*)(ws + WS_CKVN); unsigned short* const IDX = (unsigned short*)(ws + WS_IDX);
    half_t* const MIX = (half_t*)(ws + WS_BIG); half_t* const H = (half_t*)(ws + WS_BIG); half_t* const VBIG = (half_t*)(ws + WS_BIG);
    half_t* const XQ = (half_t*)(ws + WS_BIG); half_t* const XO = (half_t*)(ws + WS_BIG + 32 * MiB);
    half_t* const YA = (half_t*)(F.dout + DO_YA); half_t* const YB = (half_t*)(F.dout + DO_YB); half_t* const YC = (half_t*)(F.dout + DO_YC); half_t* const MG = (half_t*)(F.dout + DO_MG);
    float* const SCR = (float*)(F.dout + DO_SCR);
    half_t* const VOUT = (half_t*)(ws + WS_BIG + 184 * MiB);
    const float* const SMf = (const float*)(ws + WS_SMALL);
    const int cid = (int)blockIdx.x;

    for (int l = 0; l < DEPTH; ++l) {
        const int g0 = 1 + l * NSLOT;
        unsigned char* const wl = ws + WS_WL + (size_t)l * WL_STRIDE;
        half_t* const WFIN = (half_t*)(wl + WL_WFIN); half_t* const WFOUT = (half_t*)(wl + WL_WFOUT); half_t* const WMIX = (half_t*)(wl + WL_WMIX);
        half_t* const WBRA = (half_t*)(wl + WL_WBRA); half_t* const WBRB = (half_t*)(wl + WL_WBRB); half_t* const WBRC = (half_t*)(wl + WL_WBRC);
        half_t* const WMO = (half_t*)(wl + WL_WMO); half_t* const WXQ = (half_t*)(wl + WL_WXQ); half_t* const WXKV = (half_t*)(wl + WL_WXKV); half_t* const WXO = (half_t*)(wl + WL_WXO);
        for (int which = 0; which < 2; ++which) {
            const int sb = g0 + (which ? 17 : 0);
            if (RUN(sb)) REPL(REP_GEMM) {
                _Pragma("nounroll") for (int rf = 0; rf < REP_FIN; ++rf)
                { pg8::Gemm g{X, WFIN + (size_t)which * 5632 * 1024, M, 2 * DFF, D}; pg8::StaticOrder So; So.init(M, 2 * DFF, F.G, cid);
                  pg8::EpiSwiGLU E{H, DFF}; pg8::gemm_phase(F.lds, g, So, E, F.wave); }
                if (which == 0) {
                    { pg8::Gemm g{MEMH, WXKV, NB * MEM, 512, D}; pg8::StaticOrder So; So.init(NB * MEM, 512, F.G, cid);
                      pg8::EpiH E{XK, 512, nullptr, 0, 0}; pg8::gemm_phase(F.lds, g, So, E, F.wave); }
                    { pg8::Gemm g{WXKV + (size_t)512 * 1024, MEMP, 512, NB * MEM, D}; pg8::StaticOrder So; So.init(512, NB * MEM, F.G, cid);
                      pg8::EpiH E{XVT, NB * MEM, nullptr, 0, 0}; pg8::gemm_phase(F.lds, g, So, E, F.wave); }
                }
            }
            SEAM(sb);
            if (RUN(sb + 1)) REPL(REP_GEMM) { pg8::Gemm g{H, WFOUT + (size_t)which * 1024 * DFF, M, D, DFF}; pg8::StaticOrder So; So.init(M, D, F.G, cid);
                pg8::EpiRes E{X, VOUT, 0.5f}; pg8::gemm_phase(F.lds, g, So, E, F.wave); }
            SEAM(sb + 1);
            if (RUN(sb + 2)) REPL(REP_MISC) { const int li = which ? 3 : 0; p_ln(F, VOUT, SMf + SM_LNG / 4 + (size_t)(l * 4 + li) * D, SMf + SM_LNB / 4 + (size_t)(l * 4 + li) * D, (which == 1 && l == DEPTH - 1) ? (float*)F.dout : nullptr); }
            SEAM(sb + 2);
            if (which == 0) {
                for (int c = 0; c < NCHUNK; ++c) {
                    const int gm = g0 + 3 + 4 * c;
                    if (RUN(gm)) REPL(REP_GEMM) { pg8::Gemm g{X + (size_t)c * CH_ROWS * D, WMIX, CH_ROWS, NMIX, D}; pg8::StaticOrder So; So.init(CH_ROWS, NMIX, F.G, cid);
                        pg8::EpiH E{MIX, NMIX, (const float*)(wl + WL_BIAS), 18, 30}; pg8::gemm_phase(F.lds, g, So, E, F.wave); }
                    SEAM(gm);
                    if (RUN(gm + 1)) REPL(REP_M2) {
                        _Pragma("nounroll") for (int rp = 0; rp < REP_IDX; ++rp)
                        for (int k = F.vcu; k < CH_B * 256; k += F.G) idx_job(F, MIX, IDX, SCR, ((k & 3) << 8) | (255 - (k >> 2)));
                        F.lane = opaque_lane(); F.tid = F.wave * 64 + F.lane;
                        _Pragma("nounroll") for (int rp = 0; rp < REP_SB; ++rp)
                        for (int j = F.vcu * NWAVES + F.wave; j < CH_B * 8 * 128; j += F.G * NWAVES) sb_job(F, MIX, YB, j);
                        F.lane = opaque_lane(); F.tid = F.wave * 64 + F.lane;
                        for (int j = F.vcu * NWAVES + F.wave; j < CH_ROWS / 4; j += F.G * NWAVES) rms_job(F, MIX, CKVN, SMf + SM_KVG / 4 + (size_t)l * 128, j);
                        for (int j = F.vcu * NWAVES + F.wave; j < CH_ROWS / 8; j += F.G * NWAVES) conv_job(F, MIX, YC, SMf + SM_CONV / 4 + (size_t)l * 3 * 512, j);
                    }
                    SEAM(gm + 1);
                    if (RUN(gm + 2)) REPL(REP_M3) {
                        ga_tables(F);
                        const int per = (CH_ROWS + F.G - 1) / F.G, r0 = F.vcu * per, r1 = (r0 + per) < CH_ROWS ? (r0 + per) : CH_ROWS;
                        for (int row = r0 + F.wave; row < r1; row += NWAVES) ga_job(F, MIX, CKVN, IDX, YA, row);
                    }
                    SEAM(gm + 2);
                    if (RUN(gm + 3)) REPL(REP_GEMM) {
                        half_t* mgc = MG + (size_t)c * CH_ROWS * D;
                        { pg8::Gemm g{YA, WBRA, CH_ROWS, D, 1024}; pg8::StaticOrder So; So.init(CH_ROWS, D, F.G, cid); pg8::EpiGate<true> E{MIX + C_G, NMIX, mgc}; pg8::gemm_phase(F.lds, g, So, E, F.wave); }
                        { pg8::Gemm g{YB, WBRB, CH_ROWS, D, 512}; pg8::StaticOrder So; So.init(CH_ROWS, D, F.G, cid); pg8::EpiGate<false> E{MIX + C_G + 1024, NMIX, mgc}; pg8::gemm_phase(F.lds, g, So, E, F.wave); }
                        { pg8::Gemm g{YC, WBRC, CH_ROWS, D, 512}; pg8::StaticOrder So; So.init(CH_ROWS, D, F.G, cid); pg8::EpiGate<false> E{MIX + C_G + 2048, NMIX, mgc}; pg8::gemm_phase(F.lds, g, So, E, F.wave); }
                    }
                    SEAM(gm + 3);
                }
                if (RUN(g0 + 11)) REPL(REP_GEMM) { pg8::Gemm g{MG, WMO, M, D, D}; pg8::StaticOrder So; So.init(M, D, F.G, cid); pg8::EpiRes E{X, VBIG, 1.0f}; pg8::gemm_phase(F.lds, g, So, E, F.wave); }
                SEAM(g0 + 11);
                if (RUN(g0 + 12)) REPL(REP_MISC) p_ln(F, VBIG, SMf + SM_LNG / 4 + (size_t)(l * 4 + 1) * D, SMf + SM_LNB / 4 + (size_t)(l * 4 + 1) * D, nullptr);
                SEAM(g0 + 12);
                if (RUN(g0 + 13)) REPL(REP_GEMM) { pg8::Gemm g{X, WXQ, M, 512, D}; pg8::StaticOrder So; So.init(M, 512, F.G, cid); pg8::EpiH E{XQ, 512, nullptr, 0, 0}; pg8::gemm_phase(F.lds, g, So, E, F.wave); }
                SEAM(g0 + 13);
                if (RUN(g0 + 14)) REPL(REP_XA) { for (int j = F.vcu * NWAVES + F.wave; j < NB * 4 * 128; j += F.G * NWAVES) xa_job(F, XQ, XK, XVT, XO, j); }
                SEAM(g0 + 14);
                if (RUN(g0 + 15)) REPL(REP_GEMM) { pg8::Gemm g{XO, WXO, M, D, 512}; pg8::StaticOrder So; So.init(M, D, F.G, cid); pg8::EpiRes E{X, VOUT, 1.0f}; pg8::gemm_phase(F.lds, g, So, E, F.wave); }
                SEAM(g0 + 15);
                if (RUN(g0 + 16)) REPL(REP_MISC) p_ln(F, VOUT, SMf + SM_LNG / 4 + (size_t)(l * 4 + 2) * D, SMf + SM_LNB / 4 + (size_t)(l * 4 + 2) * D, nullptr);
                SEAM(g0 + 16);
            }
        }
    }
#undef RUN
#undef SEAM
#undef REPL
}

extern "C" void kernel_launch(void* const* d_in, const int* in_sizes, int n_in, void* d_out, int out_size, void* d_ws, size_t ws_size, hipStream_t stream) {
    static int grid = 0;
    if (grid == 0) {
        if (n_in != 18 || out_size != M * D || ws_size < WS_END) { fprintf(stderr, "kernel_launch: unexpected shapes (n_in %d out %d ws %zu need %zu)\n", n_in, out_size, ws_size, (size_t)WS_END); grid = -1; return; }
        int dev = 0, cus = 0, per_cu = 0;
        if (hipGetDevice(&dev) != hipSuccess || hipDeviceGetAttribute(&cus, hipDeviceAttributeMultiprocessorCount, dev) != hipSuccess) { grid = -1; return; }
        if (hipFuncSetAttribute((const void*)fwd, hipFuncAttributeMaxDynamicSharedMemorySize, LDS_BYTES) != hipSuccess) { fprintf(stderr, "kernel_launch: hipFuncSetAttribute failed\n"); grid = -1; return; }
        if (hipOccupancyMaxActiveBlocksPerMultiprocessor(&per_cu, (const void*)fwd, NWAVES * 64, LDS_BYTES) != hipSuccess || per_cu < 1) { fprintf(stderr, "kernel_launch: occupancy query says %d\n", per_cu); }
        (void)hipGetLastError();
        grid = cus;
    }
    if (grid < 0) return;
    if (hipMemsetAsync((char*)d_ws + WS_CTL, 0, CTL_ZERO_BYTES, stream) != hipSuccess) return;
    Args a{};
    for (int i = 0; i < 18; ++i) a.in[i] = (const float*)d_in[i];
    a.out = (float*)d_out; a.ws = (unsigned char*)d_ws;
#if MK_N_LAUNCHES == 1
    a.ph_lo = 0; a.ph_hi = NPHASE;
    hipLaunchKernelGGL(fwd, dim3(grid), dim3(NWAVES * 64), LDS_BYTES, stream, a);
#else
    for (int p = 0; p < NPHASE; ++p) { a.ph_lo = p; a.ph_hi = p + 1; hipLaunchKernelGGL(fwd, dim3(grid), dim3(NWAVES * 64), LDS_BYTES, stream, a); }
#endif
}
```

```cpp
#define MK_N_LAUNCHES 1
#include <hip/hip_runtime.h>
#include <cstdio>
#include <cstdint>

#define LAS __attribute__((address_space(3)))
#define GAS __attribute__((address_space(1)))
typedef _Float16 half_t;
typedef _Float16 h8 __attribute__((ext_vector_type(8)));
typedef _Float16 h4 __attribute__((ext_vector_type(4)));
typedef _Float16 h2 __attribute__((ext_vector_type(2)));
typedef float f32x4 __attribute__((ext_vector_type(4)));
typedef float f32x16 __attribute__((ext_vector_type(16)));
typedef short s4v __attribute__((ext_vector_type(4)));
typedef short s8v __attribute__((ext_vector_type(8)));
typedef unsigned u32x4 __attribute__((ext_vector_type(4)));
typedef unsigned u32x2 __attribute__((ext_vector_type(2)));

constexpr int D = 1024, NB = 8, S = 4096, DEPTH = 2, MEM = 256, DFF = 2816, PT = 7368;
constexpr int M = NB * S;
constexpr int CH_ROWS = 16384, NCHUNK = 2, CH_B = 4;
constexpr int NMIX = 7936;
constexpr int O_QA = 0, O_CKV = 512, O_IQ = 640, O_IK = 1152, O_IW = 1216, O_QS = 1224, O_KS = 1736, O_VS = 2248, O_CB = 2760, O_CC = 3272, O_CH = 3784, O_GA = 4296;
constexpr int C_QL = 0, C_IQ = 1024, C_QS = 1536, C_KS = 2048, C_VS = 2560, C_CB = 3072, C_CC = 3584, C_CH = 4096, C_G = 4608, C_CKV = 7680, C_IK = 7808, C_IW = 7872;
constexpr float ALPHA = 1.4142135623730951f, LN_EPS = 1e-5f, LOG2E = 1.4426950408889634f;

struct T5Tab { unsigned char v[128]; };
constexpr T5Tab make_t5() {
    T5Tab t{};
    for (int n = 0; n < 128; ++n) {
        if (n < 16) { t.v[n] = (unsigned char)n; continue; }
        unsigned __int128 p = 1; for (int i = 0; i < 16; ++i) p *= (unsigned __int128)n;
        int k = 0; for (int kk = 0; kk <= 15; ++kk) { if (p >= ((unsigned __int128)1 << (3 * kk + 64))) k = kk; }
        int bk = 16 + k; if (bk > 31) bk = 31; t.v[n] = (unsigned char)bk;
    }
    return t;
}
__device__ const T5Tab T5 = make_t5();

constexpr size_t MiB = 1u << 20;
constexpr size_t WS_CTL = 0, CTL_ZERO_BYTES = 1 * MiB;
constexpr size_t WS_WL = 1 * MiB, WL_STRIDE = 60 * MiB;
constexpr size_t WL_WFIN = 0;
constexpr size_t WL_WFOUT = WL_WFIN + 22 * MiB;
constexpr size_t WL_WMIX = WL_WFOUT + 11 * MiB;
constexpr size_t WL_WBRA = WL_WMIX + 16 * MiB;
constexpr size_t WL_WBRB = WL_WBRA + 2 * MiB;
constexpr size_t WL_WBRC = WL_WBRB + 1 * MiB;
constexpr size_t WL_WMO = WL_WBRC + 1 * MiB;
constexpr size_t WL_WXQ = WL_WMO + 2 * MiB;
constexpr size_t WL_WXKV = WL_WXQ + 1 * MiB;
constexpr size_t WL_WXO = WL_WXKV + 2 * MiB;
constexpr size_t WL_BIAS = WL_WXO + 1 * MiB;
static_assert(WL_BIAS + 1 * MiB <= WL_STRIDE, "layer weight block");
constexpr size_t WS_MEMH = WS_WL + 2 * WL_STRIDE;
constexpr size_t WS_MEMP = WS_MEMH + 4 * MiB;
constexpr size_t WS_SMALL = WS_MEMP + 4 * MiB;
constexpr size_t SM_LNG = 0, SM_LNB = 32768, SM_KVG = 65536, SM_CONV = 65536 + 1024, SM_RB = 65536 + 1024 + 24576;
constexpr size_t WS_XK = WS_SMALL + 1 * MiB;
constexpr size_t WS_XVT = WS_XK + 2 * MiB;
constexpr size_t WS_X = WS_XVT + 2 * MiB;
constexpr size_t WS_CKVN = WS_X + 64 * MiB;
constexpr size_t WS_IDX = WS_CKVN + 4 * MiB;
constexpr size_t WS_BIG = WS_IDX + 8 * MiB;
constexpr size_t WS_END = WS_BIG + 248 * MiB;
static_assert(WS_END <= 512 * MiB, "workspace map");
constexpr size_t DO_MG = 0, DO_YA = 64 * MiB, DO_YB = 96 * MiB, DO_YC = 112 * MiB, DO_SCR = 32 * MiB;
constexpr int CW_BAR = 4096;

constexpr int RING_BYTES = 131072, LDSCTL_OFF = RING_BYTES, MISC_OFF = LDSCTL_OFF + 320, LDS_BYTES = 147456;
constexpr int NWAVES = 8;

#define LDS_WAIT() asm volatile("s_waitcnt lgkmcnt(0)" ::: "memory")
#define VM_WAIT() asm volatile("s_waitcnt vmcnt(0)" ::: "memory")
#define CFENCE() asm volatile("" ::: "memory")

__device__ __forceinline__ h8 pack8(float a0, float a1, float a2, float a3, float a4, float a5, float a6, float a7) {
    h8 r; r[0] = (half_t)a0; r[1] = (half_t)a1; r[2] = (half_t)a2; r[3] = (half_t)a3; r[4] = (half_t)a4; r[5] = (half_t)a5; r[6] = (half_t)a6; r[7] = (half_t)a7; return r;
}
__device__ __forceinline__ h4 pack4(float a0, float a1, float a2, float a3) { h4 r; r[0] = (half_t)a0; r[1] = (half_t)a1; r[2] = (half_t)a2; r[3] = (half_t)a3; return r; }
__device__ __forceinline__ int opaque_lane() { int x; asm volatile("v_mbcnt_lo_u32_b32 %0, -1, 0\n\tv_mbcnt_hi_u32_b32 %0, -1, %0" : "=v"(x)); return x; }
__device__ __forceinline__ int opaque_tid() { const int w = __builtin_amdgcn_readfirstlane((int)threadIdx.x >> 6); return w * 64 + opaque_lane(); }
__device__ __forceinline__ float ex2(float x) { return __builtin_amdgcn_exp2f(x); }
__device__ __forceinline__ float lg2(float x) { return __builtin_amdgcn_logf(x); }

namespace pg8 {
constexpr int BM = 256, BK = 64, HALF = 128, HTB = HALF * BK * 2, STAGE_BYTES = 8 * HTB, NXCD = 8, WGM = 8;
__host__ __device__ __forceinline__ int lds_byte(int r, int c) { const int st = (r >> 4) * 2 + (c >> 5), rr = r & 15, cc = c & 31, ob = rr * 64 + cc * 2; return st * 1024 + (ob ^ (((ob >> 9) & 1) << 5)); }
__host__ __device__ __forceinline__ void stage_rc(int b, int& R, int& C) { const int st = b / 1024, sb = b % 1024, swz = sb ^ (((sb >> 9) & 1) << 5); R = (st >> 1) * 16 + swz / 64; C = (st & 1) * 32 + (swz % 64) / 2; }
__host__ __device__ __forceinline__ int perm32(int rho) { const int n = rho >> 4, i = rho & 15; return 8 * (i >> 2) + 4 * n + (i & 3); }
struct Unit { int pm, pn; };
struct Gemm { const half_t* A; const half_t* Bt; int M, N, K; };
struct StaticOrder {
    int nM, nN, nwg, G, c;
    __host__ __device__ void init(int M_, int N_, int G_, int c_) { nM = M_ / BM; nN = N_ / BM; nwg = nM * nN; G = G_; c = c_; }
    __host__ __device__ bool next(int i, Unit& u) const {
        const long L = (long)i * G + c; if (L >= nwg) return false;
        int wgid = (int)L; { const int q = nwg / NXCD, r = nwg % NXCD, xcd = wgid % NXCD, off = wgid / NXCD; wgid = (xcd < r ? xcd * (q + 1) : r * (q + 1) + (xcd - r) * q) + off; }
        const int nig = WGM * nN, gid = wgid / nig, fm = gid * WGM, gsz = (nM - fm) < WGM ? (nM - fm) : WGM;
        u.pm = fm + ((wgid % nig) % gsz); u.pn = (wgid % nig) / gsz; return true;
    }
    __device__ __forceinline__ void a_ready(const Unit&) const {}
    __device__ __forceinline__ void done(const Unit&) const {}
};
typedef f32x4 Acc[2][2][4][2];

struct EpiH {
    half_t* O; int ldc; const float* bias; int sig_lo, sig_hi;
    __device__ __forceinline__ void operator()(const Acc& acc, const Unit& u, int wr, int wc, int fr, int fq) const {
        const int row0 = u.pm * BM + wr * 64 + fr, col0 = u.pn * BM + wc * 32 + 8 * fq;
        const bool sig = u.pn >= sig_lo && u.pn < sig_hi;
        f32x4 bv[2][2];
#pragma unroll
        for (int bj = 0; bj < 2; ++bj)
#pragma unroll
            for (int n = 0; n < 2; ++n) bv[bj][n] = bias ? *(const f32x4*)(bias + col0 + bj * HALF + 4 * n) : (f32x4){0.f, 0.f, 0.f, 0.f};
#pragma unroll
        for (int ai = 0; ai < 2; ++ai)
#pragma unroll
            for (int m = 0; m < 4; ++m) { half_t* rowp = O + (size_t)(row0 + ai * HALF + m * 16) * ldc + col0;
#pragma unroll
                for (int bj = 0; bj < 2; ++bj) { f32x4 v0 = acc[ai][bj][m][0] + bv[bj][0], v1 = acc[ai][bj][m][1] + bv[bj][1];
                    if (sig) {
#pragma unroll
                        for (int j = 0; j < 4; ++j) { v0[j] = __builtin_amdgcn_rcpf(1.f + ex2(-LOG2E * v0[j])); v1[j] = __builtin_amdgcn_rcpf(1.f + ex2(-LOG2E * v1[j])); } }
                    *(h8*)(rowp + bj * HALF) = pack8(v0[0], v0[1], v0[2], v0[3], v1[0], v1[1], v1[2], v1[3]); } }
    }
};
struct EpiSwiGLU {
    half_t* O; int ldc;
    __device__ __forceinline__ void operator()(const Acc& acc, const Unit& u, int wr, int wc, int fr, int fq) const {
        const int row0 = u.pm * BM + wr * 64 + fr, col0 = u.pn * HALF + wc * 32 + 8 * fq;
#pragma unroll
        for (int ai = 0; ai < 2; ++ai)
#pragma unroll
            for (int m = 0; m < 4; ++m) { half_t* rowp = O + (size_t)(row0 + ai * HALF + m * 16) * ldc + col0; float o[8];
#pragma unroll
                for (int n = 0; n < 2; ++n)
#pragma unroll
                    for (int j = 0; j < 4; ++j) { const float a = acc[ai][0][m][n][j], b = acc[ai][1][m][n][j]; o[4 * n + j] = a * __builtin_amdgcn_rcpf(1.f + ex2(-LOG2E * a)) * b; }
                *(h8*)rowp = pack8(o[0], o[1], o[2], o[3], o[4], o[5], o[6], o[7]); }
    }
};
struct EpiRes {
    const half_t* X; half_t* V; float s;
    __device__ __forceinline__ void operator()(const Acc& acc, const Unit& u, int wr, int wc, int fr, int fq) const {
        const int row0 = u.pm * BM + wr * 64 + fr, col0 = u.pn * BM + wc * 32 + 8 * fq;
#pragma unroll
        for (int ai = 0; ai < 2; ++ai)
#pragma unroll
            for (int m = 0; m < 4; ++m) { const size_t off = (size_t)(row0 + ai * HALF + m * 16) * D + col0;
#pragma unroll
                for (int bj = 0; bj < 2; ++bj) { const h8 xv = *(const h8*)(X + off + bj * HALF); float o[8];
#pragma unroll
                    for (int j = 0; j < 4; ++j) { o[j] = ALPHA * (float)xv[j] + s * acc[ai][bj][m][0][j]; o[4 + j] = ALPHA * (float)xv[4 + j] + s * acc[ai][bj][m][1][j]; }
                    *(h8*)(V + off + bj * HALF) = pack8(o[0], o[1], o[2], o[3], o[4], o[5], o[6], o[7]); } }
    }
};
template <bool FIRST> struct EpiGate {
    const half_t* G; int ldg; half_t* MG;
    __device__ __forceinline__ void operator()(const Acc& acc, const Unit& u, int wr, int wc, int fr, int fq) const {
        const int row0 = u.pm * BM + wr * 64 + fr, col0 = u.pn * BM + wc * 32 + 8 * fq;
#pragma unroll
        for (int ai = 0; ai < 2; ++ai)
#pragma unroll
            for (int m = 0; m < 4; ++m) { const int row = row0 + ai * HALF + m * 16;
#pragma unroll
                for (int bj = 0; bj < 2; ++bj) { const h8 gv = *(const h8*)(G + (size_t)row * ldg + col0 + bj * HALF); half_t* mp = MG + (size_t)row * D + col0 + bj * HALF; float o[8];
#pragma unroll
                    for (int j = 0; j < 4; ++j) { o[j] = (float)gv[j] * acc[ai][bj][m][0][j]; o[4 + j] = (float)gv[4 + j] * acc[ai][bj][m][1][j]; }
                    if (!FIRST) { const h8 pv = *(const h8*)mp;
#pragma unroll
                        for (int j = 0; j < 8; ++j) o[j] += (float)pv[j]; }
                    *(h8*)mp = pack8(o[0], o[1], o[2], o[3], o[4], o[5], o[6], o[7]); } }
    }
};

template <class Epi, class Sched>
__device__ __forceinline__ void gemm_phase(LAS unsigned char* lds, const Gemm g, const Sched& Sd, const Epi& E, int wid) {
    const int lane = opaque_lane(), tid = wid * 64 + lane, wr = wid >> 2, wc = wid & 3, fr = lane & 15, fq = lane >> 4;
    const int K = g.K, nt = K / BK;
    unsigned voffA[2], voffB[2];
#pragma unroll
    for (int i = 0; i < 2; ++i) { int R, C; stage_rc(tid * 16 + i * 8192, R, C); const int Rb = (R & ~31) + perm32(R & 31);
        voffA[i] = (unsigned)(R * K + C) * 2u; voffB[i] = (unsigned)(Rb * K + C) * 2u; }
    const size_t kstep = (size_t)(BK * 2);
    const size_t hstep = (size_t)HALF * K * 2;
    const size_t tstep = 2 * hstep;
    const unsigned ldsw = (unsigned)wid * 1024u;
    const int aoff = lds_byte(wr * 64 + fr, fq * 8), boff = lds_byte(wc * 32 + fr, fq * 8);
#define PG8_SA(b, h) (((b) * 2 + (h)) * HTB)
#define PG8_SB(b, h) ((4 + (b) * 2 + (h)) * HTB)
#define PG8_STAGE(bufoff, gbase, voff) do { _Pragma("unroll") for (int _i = 0; _i < 2; ++_i) \
        __builtin_amdgcn_global_load_lds((const unsigned*)((const char*)(gbase) + (voff)[_i]), (LAS unsigned*)(lds + (bufoff) + ldsw + _i * 8192), 16, 0, 0); } while (0)
#define PG8_LDA(dst, b, h) do { _Pragma("unroll") for (int m = 0; m < 4; ++m) _Pragma("unroll") for (int k = 0; k < 2; ++k) dst[m][k] = *(const LAS h8*)(lds + PG8_SA(b, h) + aoff + m * 2048 + k * 1024); } while (0)
#define PG8_LDB(dst, b, h) do { _Pragma("unroll") for (int n = 0; n < 2; ++n) _Pragma("unroll") for (int k = 0; k < 2; ++k) dst[n][k] = *(const LAS h8*)(lds + PG8_SB(b, h) + boff + n * 2048 + k * 1024); } while (0)
#define PG8_MMA(ai, bj, At, Bt) do { __builtin_amdgcn_s_setprio(1); _Pragma("unroll") for (int m = 0; m < 4; ++m) _Pragma("unroll") for (int n = 0; n < 2; ++n) _Pragma("unroll") for (int k = 0; k < 2; ++k) \
        acc[ai][bj][m][n] = __builtin_amdgcn_mfma_f32_16x16x32_f16(Bt[n][k], At[m][k], acc[ai][bj][m][n], 0, 0, 0); __builtin_amdgcn_s_setprio(0); } while (0)
#define PG8_WAIT_V(n) asm volatile("s_waitcnt vmcnt(" #n ")" ::: "memory")
#define PG8_WAIT_L(n) asm volatile("s_waitcnt lgkmcnt(" #n ")" ::: "memory")
#define PG8_BAR __builtin_amdgcn_s_barrier()
#define PG8_SCHED __builtin_amdgcn_sched_barrier(0)
    Unit cur, nxt; int ui = 0;
    if (!Sd.next(0, cur)) return;
    Acc acc;
#pragma unroll
    for (int a = 0; a < 2; ++a)
#pragma unroll
        for (int b = 0; b < 2; ++b)
#pragma unroll
            for (int m = 0; m < 4; ++m)
#pragma unroll
                for (int n = 0; n < 2; ++n) acc[a][b][m][n] = (f32x4){0.f, 0.f, 0.f, 0.f};
    h8 At[4][2], B0[2][2], B1[2][2];
    const char* cA = (const char*)g.A + (size_t)cur.pm * tstep; const char* cB = (const char*)g.Bt + (size_t)cur.pn * tstep;
    Sd.a_ready(cur);
    PG8_STAGE(PG8_SB(0, 0), cB, voffB); PG8_STAGE(PG8_SB(0, 1), cB + hstep, voffB); PG8_STAGE(PG8_SA(0, 0), cA, voffA); PG8_STAGE(PG8_SA(0, 1), cA + hstep, voffA);
    if (wr == 1) PG8_BAR;
    PG8_WAIT_V(2); PG8_BAR;
    PG8_STAGE(PG8_SB(1, 0), cB + kstep, voffB); PG8_STAGE(PG8_SA(1, 0), cA + kstep, voffA); PG8_STAGE(PG8_SB(1, 1), cB + hstep + kstep, voffB);
    PG8_WAIT_V(6); PG8_BAR;
    for (;;) {
        const bool has_next = Sd.next(ui + 1, nxt);
        const char* nA = has_next ? (const char*)g.A + (size_t)nxt.pm * tstep : cA; const char* nB = has_next ? (const char*)g.Bt + (size_t)nxt.pn * tstep : cB;
        for (int t = 0; t < nt; t += 2) {
            const bool last = (t == nt - 2);
            const char* a1 = cA + (size_t)(t + 1) * kstep;
            const char* a2 = last ? nA : cA + (size_t)(t + 2) * kstep; const char* b2 = last ? nB : cB + (size_t)(t + 2) * kstep;
            const char* a3 = a2 + kstep; const char* b3 = b2 + kstep;
            if (last && has_next) Sd.a_ready(nxt);
            PG8_LDB(B0, 0, 0); PG8_LDB(B1, 0, 1); PG8_SCHED; PG8_LDA(At, 0, 0); PG8_STAGE(PG8_SA(1, 1), a1 + hstep, voffA);
            PG8_WAIT_V(8); PG8_WAIT_L(0); PG8_BAR; PG8_MMA(0, 0, At, B0); PG8_MMA(0, 1, At, B1); PG8_BAR; PG8_SCHED;
            PG8_LDA(At, 0, 1); PG8_STAGE(PG8_SB(0, 0), b2, voffB); PG8_STAGE(PG8_SB(0, 1), b2 + hstep, voffB); PG8_STAGE(PG8_SA(0, 0), a2, voffA);
            PG8_WAIT_V(8); PG8_WAIT_L(0); PG8_BAR; PG8_MMA(1, 0, At, B0); PG8_MMA(1, 1, At, B1); PG8_BAR; PG8_SCHED;
            PG8_LDB(B0, 1, 0); PG8_LDB(B1, 1, 1); PG8_SCHED; PG8_LDA(At, 1, 0); PG8_STAGE(PG8_SA(0, 1), a2 + hstep, voffA);
            PG8_WAIT_V(8); PG8_WAIT_L(0); PG8_BAR; PG8_MMA(0, 0, At, B0); PG8_MMA(0, 1, At, B1); PG8_BAR; PG8_SCHED;
            PG8_LDA(At, 1, 1); PG8_STAGE(PG8_SB(1, 0), b3, voffB); PG8_STAGE(PG8_SB(1, 1), b3 + hstep, voffB); PG8_STAGE(PG8_SA(1, 0), a3, voffA);
            PG8_WAIT_V(8); PG8_WAIT_L(0); PG8_BAR; PG8_MMA(1, 0, At, B0); PG8_MMA(1, 1, At, B1); PG8_BAR; PG8_SCHED;
        }
        if (wr == 0) PG8_BAR;
        E(acc, cur, wr, wc, fr, fq); Sd.done(cur);
        if (!has_next) break;
#pragma unroll
        for (int a = 0; a < 2; ++a)
#pragma unroll
            for (int b = 0; b < 2; ++b)
#pragma unroll
                for (int m = 0; m < 4; ++m)
#pragma unroll
                    for (int n = 0; n < 2; ++n) acc[a][b][m][n] = (f32x4){0.f, 0.f, 0.f, 0.f};
        cur = nxt; cA = nA; cB = nB; ++ui;
        if (wr == 1) PG8_BAR;
    }
    PG8_WAIT_V(0);
    PG8_BAR;
#undef PG8_SA
#undef PG8_SB
#undef PG8_STAGE
#undef PG8_LDA
#undef PG8_LDB
#undef PG8_MMA
#undef PG8_WAIT_V
#undef PG8_WAIT_L
#undef PG8_BAR
#undef PG8_SCHED
}
}
#define XB_TMO      128
#define XB_XCNT(j)  (256  + 64 * (j))
#define XB_XSUB(j)  (1280 + 64 * (j))
#define XB_XGEN(j)  (2304 + 64 * (j))
#define XB_TOP      3328
#define XB_TOPGEN   3392
#define XCD_BAR_WORDS 3456
#define XB_SPIN_CAP (1u << 18)
__device__ __forceinline__ unsigned xb_ld(unsigned* p)              { return __hip_atomic_load(p, __ATOMIC_RELAXED, __HIP_MEMORY_SCOPE_AGENT); }
__device__ __forceinline__ unsigned xb_add(unsigned* p, unsigned v) { return __hip_atomic_fetch_add(p, v, __ATOMIC_RELAXED, __HIP_MEMORY_SCOPE_AGENT); }
__device__ __forceinline__ unsigned xb_xcc_id() { return (unsigned)__builtin_amdgcn_s_getreg((3 << 11) | 20) & 0xFu; }
#define XB_SPIN(cond, bar) do { unsigned _sp = 0; while (cond) { __builtin_amdgcn_s_sleep(1); \
    if ((++_sp & 255u) == 0u) { if (xb_ld(&(bar)[XB_TMO])) break; if (_sp > XB_SPIN_CAP) { atomicAdd(&(bar)[XB_TMO], 1u); break; } } } } while (0)
struct XcdBarrier { unsigned* bar; unsigned x; volatile LAS unsigned* st; int wave; };
__device__ __forceinline__ XcdBarrier xcd_barrier_post(unsigned* bar, volatile LAS unsigned* st, int wave) {
    XcdBarrier b; b.bar = bar; b.x = xb_xcc_id(); b.st = st; b.wave = wave;
    if (wave == 0 && opaque_lane() == 0) (void)xb_add(&bar[XB_XCNT(b.x)], 1u);
    return b;
}
__device__ __forceinline__ void xcd_barrier_complete(unsigned* bar, unsigned x, unsigned& nloc, unsigned& nx) {
    const unsigned G = gridDim.x * gridDim.y * gridDim.z;
    unsigned sum, cnt, mine, sp = 0u;
    for (;;) {
        sum = 0u; cnt = 0u; mine = 0u;
#pragma unroll
        for (unsigned j = 0; j < 16; ++j) { const unsigned c = xb_ld(&bar[XB_XCNT(j)]); sum += c; cnt += (c > 0u) ? 1u : 0u; mine = (j == x) ? c : mine; }
        if (sum == G) break;
        __builtin_amdgcn_s_sleep(1);
        if ((++sp & 255u) == 0u) { if (xb_ld(&bar[XB_TMO])) break; if (sp > XB_SPIN_CAP) { atomicAdd(&bar[XB_TMO], 1u); break; } }
    }
    nloc = mine > 0u ? mine : 1u; nx = cnt > 0u ? cnt : 1u;
}
__device__ __forceinline__ void xcd_barrier(const XcdBarrier& b) {
    asm volatile("s_waitcnt vmcnt(0)" ::: "memory");
    __syncthreads();
    if (b.wave == 0 && opaque_lane() == 0) {
        unsigned* bar = b.bar;
        __builtin_amdgcn_s_waitcnt(0);
        unsigned nloc = b.st[0], nx = b.st[1];
        if (nloc == 0u) { xcd_barrier_complete(bar, b.x, nloc, nx); b.st[0] = nloc; b.st[1] = nx; }
        const unsigned old = xb_add(&bar[XB_XSUB(b.x)], 1u);
        const unsigned gen = old / nloc;
        if (old + 1u == (gen + 1u) * nloc) {
            __builtin_amdgcn_fence(__ATOMIC_RELEASE, "agent");
            asm volatile("s_waitcnt vmcnt(0)" ::: "memory");
            const unsigned og = xb_add(&bar[XB_TOP], 1u);
            const unsigned tg = og / nx;
            if (og + 1u == (tg + 1u) * nx) xb_add(&bar[XB_TOPGEN], 1u);
            else XB_SPIN(xb_ld(&bar[XB_TOPGEN]) == tg, bar);
            __builtin_amdgcn_fence(__ATOMIC_ACQUIRE, "agent");
            xb_add(&bar[XB_XGEN(b.x)], 1u);
            asm volatile("s_waitcnt vmcnt(0)" ::: "memory");
        } else {
            XB_SPIN(xb_ld(&bar[XB_XGEN(b.x)]) == gen, bar);
            __builtin_amdgcn_fence(__ATOMIC_ACQUIRE, "agent");
            asm volatile("s_waitcnt vmcnt(0)" ::: "memory");
        }
    }
    __syncthreads();
}

struct Frame {
    LAS unsigned char* lds;
    int tid, lane, wave, vcu, G;
    const float *x_in, *mem, *ln_g, *ln_b, *ffn_w_in, *ffn_w_out, *w_mix_in, *b_gate, *kv_g, *w_uk, *w_uv, *conv_w, *w_branch, *w_mix_out, *xa_wq, *xa_wkv, *xa_wo, *rel_bias;
    unsigned char* ws; unsigned char* dout;
};
__device__ __forceinline__ float wave_sum(float v) {
#pragma unroll
    for (int o = 1; o < 64; o <<= 1) v += __shfl_xor(v, o);
    return v;
}

__device__ __forceinline__ void tr_item(const float* W, int ldw, int c0, half_t* dst, int K, int r0, int k0, float scale, LAS float* scr, int lane) {
#pragma unroll 8
    for (int i = 0; i < 32; ++i) { const int kk = 2 * i + (lane >> 5); scr[kk * 33 + (lane & 31)] = W[(size_t)(k0 + kk) * ldw + c0 + (lane & 31)]; }
    LDS_WAIT(); CFENCE();
    const int c = lane & 7;
#pragma unroll
    for (int j = 0; j < 4; ++j) { const int n = (lane >> 3) + 8 * j; const LAS float* s = scr + (8 * c) * 33 + n;
        *(h8*)(dst + (size_t)(r0 + n) * K + k0 + 8 * c) = pack8(s[0] * scale, s[33] * scale, s[66] * scale, s[99] * scale, s[132] * scale, s[165] * scale, s[198] * scale, s[231] * scale); }
    LDS_WAIT(); CFENCE();
}
__device__ __forceinline__ void mix_src(int nb, int& c0, float& scale) {
    const int r = nb * 32; scale = 1.f;
    if (r < C_QS) { c0 = O_IQ + (r - C_IQ); }
    else if (r < C_KS) { c0 = O_QS + (r - C_QS); scale = 0.125f * LOG2E; }
    else if (r < C_VS) { c0 = O_KS + (r - C_KS); }
    else if (r < C_CB) { c0 = O_VS + (r - C_VS); }
    else if (r < C_CC) { c0 = O_CB + (r - C_CB); }
    else if (r < C_CH) { c0 = O_CC + (r - C_CC); }
    else if (r < C_G) { c0 = O_CH + (r - C_CH); }
    else if (r < C_CKV) { c0 = O_GA + (r - C_G); }
    else if (r < C_IK) { c0 = O_CKV + (r - C_CKV); }
    else { c0 = O_IK + (r - C_IK); }
}
__device__ __forceinline__ void p_prep(Frame& F, int l) {
    LAS float* scr = (LAS float*)(F.lds + F.wave * 16384);
    const int gw = F.vcu * NWAVES + F.wave, NGW = F.G * NWAVES, lane = F.lane;
    unsigned char* wl = F.ws + WS_WL + (size_t)l * WL_STRIDE;
    half_t* WFIN = (half_t*)(wl + WL_WFIN); half_t* WFOUT = (half_t*)(wl + WL_WFOUT); half_t* WMIX = (half_t*)(wl + WL_WMIX);
    half_t* WBRA = (half_t*)(wl + WL_WBRA); half_t* WBRB = (half_t*)(wl + WL_WBRB); half_t* WBRC = (half_t*)(wl + WL_WBRC);
    half_t* WMO = (half_t*)(wl + WL_WMO); half_t* WXQ = (half_t*)(wl + WL_WXQ); half_t* WXKV = (half_t*)(wl + WL_WXKV); half_t* WXO = (half_t*)(wl + WL_WXO);
    const float* w_in_l = F.w_mix_in + (size_t)l * D * PT;
    constexpr int I_FIN = 176 * 16, I_FOUT = 32 * 44, I_MIX = 214 * 16, I_BR = 32 * 8, I_MO = 32 * 16, I_XQ = 16 * 16, I_XKV = 32 * 16, I_XO = 32 * 8;
    constexpr int NITEMS = 2 * I_FIN + 2 * I_FOUT + I_MIX + 2 * I_BR + I_MO + I_XQ + I_XKV + I_XO;
    for (int it = gw; it < NITEMS; it += NGW) {
        int r = it;
        if (r < 2 * I_FIN) { const int which = r / I_FIN; r -= which * I_FIN; const int nb = r / 16, kb = r % 16, pn = nb >> 3, w8 = nb & 7;
            const int c0 = (w8 < 4) ? (128 * pn + 32 * w8) : (DFF + 128 * pn + 32 * (w8 - 4));
            tr_item(F.ffn_w_in + (size_t)(l * 2 + which) * D * 2 * DFF, 2 * DFF, c0, WFIN + (size_t)which * 5632 * 1024, 1024, nb * 32, kb * 64, 1.f, scr, lane); continue; }
        r -= 2 * I_FIN;
        if (r < 2 * I_FOUT) { const int which = r / I_FOUT; r -= which * I_FOUT; const int nb = r / 44, kb = r % 44;
            tr_item(F.ffn_w_out + (size_t)(l * 2 + which) * DFF * D, D, nb * 32, WFOUT + (size_t)which * 1024 * DFF, DFF, nb * 32, kb * 64, 1.f, scr, lane); continue; }
        r -= 2 * I_FOUT;
        if (r < I_MIX) { const int nb = 32 + r / 16, kb = r % 16; int c0; float sc; mix_src(nb, c0, sc);
            tr_item(w_in_l, PT, c0, WMIX, 1024, nb * 32, kb * 64, sc, scr, lane); continue; }
        r -= I_MIX;
        if (r < 2 * I_BR) { const int which = r / I_BR; r -= which * I_BR; const int nb = r / 8, kb = r % 8;
            tr_item(F.w_branch + (size_t)(l * 3 + 1 + which) * 512 * D, D, nb * 32, which ? WBRC : WBRB, 512, nb * 32, kb * 64, 1.f, scr, lane); continue; }
        r -= 2 * I_BR;
        if (r < I_MO) { const int nb = r / 16, kb = r % 16; tr_item(F.w_mix_out + (size_t)l * D * D, D, nb * 32, WMO, 1024, nb * 32, kb * 64, 1.f, scr, lane); continue; }
        r -= I_MO;
        if (r < I_XQ) { const int nb = r / 16, kb = r % 16; tr_item(F.xa_wq + (size_t)l * D * 512, 512, nb * 32, WXQ, 1024, nb * 32, kb * 64, 0.08838834764831845f * LOG2E, scr, lane); continue; }
        r -= I_XQ;
        if (r < I_XKV) { const int nb = r / 16, kb = r % 16; tr_item(F.xa_wkv + (size_t)l * D * 1024, 1024, nb * 32, WXKV, 1024, nb * 32, kb * 64, 1.f, scr, lane); continue; }
        r -= I_XKV;
        { const int nb = r / 8, kb = r % 8; tr_item(F.xa_wo + (size_t)l * 512 * D, D, nb * 32, WXO, 512, nb * 32, kb * 64, 1.f, scr, lane); }
    }
    for (int tk = gw; tk < 8 * 2 * 32; tk += NGW) {
        const int h = tk >> 6, chalf = (tk >> 5) & 1, kb = tk & 31, c = chalf * 64 + lane;
        float wk[64];
#pragma unroll
        for (int d = 0; d < 64; ++d) wk[d] = F.w_uk[((size_t)(l * 8 + h) * 64 + d) * 128 + c] * (0.125f * LOG2E);
#pragma unroll 1
        for (int kk = 0; kk < 32; ++kk) { const float* wr_ = w_in_l + (size_t)(kb * 32 + kk) * PT + O_QA + h * 64; float a0 = 0.f, a1 = 0.f;
#pragma unroll
            for (int d = 0; d < 64; d += 2) { a0 += wr_[d] * wk[d]; a1 += wr_[d + 1] * wk[d + 1]; }
            WMIX[(size_t)(h * 128 + c) * 1024 + kb * 32 + kk] = (half_t)(a0 + a1); }
    }
    for (int tk = gw; tk < 8 * 16 * 4; tk += NGW) {
        const int h = tk >> 6, nblk = (tk >> 2) & 15, cq = tk & 3, n = nblk * 64 + lane;
        const float* wb0 = F.w_branch + (size_t)(l * 3) * 512 * D;
        float wb[64];
#pragma unroll
        for (int d = 0; d < 64; ++d) wb[d] = wb0[(size_t)(h * 64 + d) * D + n];
#pragma unroll 1
        for (int cc = 0; cc < 32; ++cc) { const float* uv = F.w_uv + ((size_t)(l * 8 + h) * 128 + cq * 32 + cc) * 64; float a0 = 0.f, a1 = 0.f;
#pragma unroll
            for (int d = 0; d < 64; d += 2) { a0 += uv[d] * wb[d]; a1 += uv[d + 1] * wb[d + 1]; }
            WBRA[(size_t)n * 1024 + h * 128 + cq * 32 + cc] = (half_t)(a0 + a1); }
    }
    for (int i = gw * 64 + lane; i < 64 * 1024; i += NGW * 64) { const int rr = i >> 10, k = i & 1023;
        WMIX[(size_t)(C_IW + rr) * 1024 + k] = rr < 8 ? (half_t)(w_in_l[(size_t)k * PT + O_IW + rr] * (0.35355339059327373f * 0.125f)) : (half_t)0.f; }
    { float* bias = (float*)(wl + WL_BIAS);
      for (int i = gw * 64 + lane; i < NMIX; i += NGW * 64) bias[i] = (i >= C_G && i < C_CKV) ? F.b_gate[(size_t)l * 3 * D + (i - C_G)] : 0.f; }
    if (l == 0) { half_t* MEMH = (half_t*)(F.ws + WS_MEMH); half_t* MEMP = (half_t*)(F.ws + WS_MEMP);
      for (int i = gw * 64 + lane; i < 2048 * 128; i += NGW * 64) { const int row = i >> 7, c8 = (i & 127) * 8;
          const f32x4 a = *(const f32x4*)(F.mem + (size_t)row * 1024 + c8), b = *(const f32x4*)(F.mem + (size_t)row * 1024 + c8 + 4);
          const h8 v = pack8(a[0], a[1], a[2], a[3], b[0], b[1], b[2], b[3]);
          *(h8*)(MEMH + (size_t)row * 1024 + c8) = v;
          const int prow = (row & ~12) | ((row & 4) << 1) | ((row & 8) >> 1);
          *(h8*)(MEMP + (size_t)prow * 1024 + c8) = v; } }
    if (l == 0) {
        float* sm = (float*)(F.ws + WS_SMALL); const int gt = gw * 64 + lane, NT = NGW * 64;
        for (int i = gt; i < DEPTH * 4 * D; i += NT) { sm[SM_LNG / 4 + i] = F.ln_g[i]; sm[SM_LNB / 4 + i] = F.ln_b[i]; }
        for (int i = gt; i < DEPTH * 128; i += NT) sm[SM_KVG / 4 + i] = F.kv_g[i];
        for (int i = gt; i < DEPTH * 3 * 512; i += NT) sm[SM_CONV / 4 + i] = F.conv_w[i];
        for (int i = gt; i < 256; i += NT) sm[SM_RB / 4 + i] = F.rel_bias[i] * LOG2E;
    }
}
__device__ __forceinline__ void p_x_to_half(Frame& F) {
    half_t* X = (half_t*)(F.ws + WS_X); const int gt = (F.vcu * NWAVES + F.wave) * 64 + F.lane, NT = F.G * NWAVES * 64;
    for (size_t i = gt; i < (size_t)M * D / 8; i += NT) { const f32x4 a = *(const f32x4*)(F.x_in + i * 8), b = *(const f32x4*)(F.x_in + i * 8 + 4);
        *(h8*)(X + i * 8) = pack8(a[0], a[1], a[2], a[3], b[0], b[1], b[2], b[3]); }
}
__device__ __forceinline__ void p_ln(Frame& F, const half_t* V, const float* g, const float* b, float* outf) {
    half_t* X = (half_t*)(F.ws + WS_X); const int gw = F.vcu * NWAVES + F.wave, NGW = F.G * NWAVES, lane = F.lane;
    f32x4 gv[4], bv[4];
#pragma unroll
    for (int j = 0; j < 4; ++j) { gv[j] = *(const f32x4*)(g + 256 * j + 4 * lane); bv[j] = *(const f32x4*)(b + 256 * j + 4 * lane); }
    for (int m = gw; m < M; m += NGW) {
        const half_t* vr = V + (size_t)m * D; f32x4 v[4]; float s = 0.f;
#pragma unroll
        for (int j = 0; j < 4; ++j) { const h4 hv = *(const h4*)(vr + 256 * j + 4 * lane); v[j] = (f32x4){(float)hv[0], (float)hv[1], (float)hv[2], (float)hv[3]}; s += (v[j][0] + v[j][1]) + (v[j][2] + v[j][3]); }
        const float mean = wave_sum(s) * (1.f / D); float s2 = 0.f;
#pragma unroll
        for (int j = 0; j < 4; ++j) { v[j] = v[j] - mean; s2 += (v[j][0] * v[j][0] + v[j][1] * v[j][1]) + (v[j][2] * v[j][2] + v[j][3] * v[j][3]); }
        const float rstd = 1.f / sqrtf(wave_sum(s2) * (1.f / D) + LN_EPS);
#pragma unroll
        for (int j = 0; j < 4; ++j) { const f32x4 o = v[j] * rstd * gv[j] + bv[j];
            *(h4*)(X + (size_t)m * D + 256 * j + 4 * lane) = pack4(o[0], o[1], o[2], o[3]);
            if (outf) *(f32x4*)(outf + (size_t)m * D + 256 * j + 4 * lane) = o; }
    }
}
__device__ __forceinline__ h8 tr_pair(const LAS unsigned char* p0, const LAS unsigned char* p1) {
    const s4v a = __builtin_amdgcn_ds_read_tr16_b64_v4i16((LAS s4v*)p0);
    const s4v b = __builtin_amdgcn_ds_read_tr16_b64_v4i16((LAS s4v*)p1);
    const s8v r = __builtin_shufflevector(a, b, 0, 1, 2, 3, 4, 5, 6, 7);
    return __builtin_bit_cast(h8, r);
}
__device__ __forceinline__ int crow(int i, int h) { return (i & 3) + 8 * (i >> 2) + 4 * h; }

constexpr int SB_VPITCH = 144;
__device__ __forceinline__ void sb_job(Frame& F, const half_t* MIX, half_t* YB, int job) {
    const int lane = opaque_lane(), r = lane & 31, hh = lane >> 5;
    const int blk = job & 127, h = (job >> 7) & 7, b = job >> 10;
    const size_t R0 = (size_t)b * S; const int t0 = blk * 32;
    LAS unsigned char* vb = F.lds + F.wave * 8192;
    h8 qf[4];
#pragma unroll
    for (int st = 0; st < 4; ++st) qf[st] = *(const h8*)(MIX + (R0 + t0 + r) * NMIX + C_QS + h * 64 + 16 * st + 8 * hh);
    f32x16 oacc[2];
#pragma unroll
    for (int c = 0; c < 2; ++c)
#pragma unroll
        for (int i = 0; i < 16; ++i) oacc[c][i] = 0.f;
    float Rsum = 0.f;
    h8 kfn[4], vvn[4];
    { const size_t kr = R0 + (size_t)blk * 32;
#pragma unroll
      for (int st = 0; st < 4; ++st) kfn[st] = *(const h8*)(MIX + (kr + r) * NMIX + C_KS + h * 64 + 16 * st + 8 * hh);
#pragma unroll
      for (int i = 0; i < 4; ++i) vvn[i] = *(const h8*)(MIX + (kr + 8 * i + (lane >> 3)) * NMIX + C_VS + h * 64 + 8 * (lane & 7)); }
    for (int kt = blk; kt >= 0; --kt) {
        h8 kf[4], vv[4];
#pragma unroll
        for (int st = 0; st < 4; ++st) { kf[st] = kfn[st]; vv[st] = vvn[st]; }
        if (kt > 0) {
            const size_t kr = R0 + (size_t)(kt - 1) * 32;
#pragma unroll
            for (int st = 0; st < 4; ++st) kfn[st] = *(const h8*)(MIX + (kr + r) * NMIX + C_KS + h * 64 + 16 * st + 8 * hh);
#pragma unroll
            for (int i = 0; i < 4; ++i) vvn[i] = *(const h8*)(MIX + (kr + 8 * i + (lane >> 3)) * NMIX + C_VS + h * 64 + 8 * (lane & 7));
        }
        f32x16 sacc;
#pragma unroll
        for (int i = 0; i < 16; ++i) sacc[i] = 0.f;
#pragma unroll
        for (int st = 0; st < 4; ++st) sacc = __builtin_amdgcn_mfma_f32_32x32x16_f16(kf[st], qf[st], sacc, 0, 0, 0);
        CFENCE();
#pragma unroll
        for (int i = 0; i < 4; ++i) *(LAS h8*)(vb + (8 * i + (lane >> 3)) * SB_VPITCH + 16 * (lane & 7)) = vv[i];
        CFENCE();
        if (kt == blk) {
            int rr = r; asm volatile("" : "+v"(rr));
#pragma unroll
            for (int i = 0; i < 16; ++i) sacc[i] = (crow(i, hh) < rr) ? sacc[i] : -1e30f;
        }
        float L[16], zl[16];
#pragma unroll
        for (int i = 0; i < 16; ++i) {
            const float z = sacc[i]; const float sp = fmaxf(z, 0.f) + lg2(1.f + ex2(-fabsf(z)));
            L[i] = -sp; zl[i] = z - sp;
        }
        float bs[4], pbs[4];
#pragma unroll
        for (int q = 0; q < 4; ++q) { bs[q] = (L[4 * q] + L[4 * q + 1]) + (L[4 * q + 2] + L[4 * q + 3]); pbs[q] = __shfl_xor(bs[q], 32); }
        float after[4]; after[3] = 0.f; after[2] = bs[3] + pbs[3]; after[1] = after[2] + (bs[2] + pbs[2]); after[0] = after[1] + (bs[1] + pbs[1]);
        const float tile_total = after[0] + (bs[0] + pbs[0]);
        float p[16];
#pragma unroll
        for (int q = 0; q < 4; ++q) {
            const float base = Rsum + after[q] + (hh == 0 ? pbs[q] : 0.f);
            const float s3 = base, s2 = s3 + L[4 * q + 3], s1 = s2 + L[4 * q + 2], s0 = s1 + L[4 * q + 1];
            p[4 * q + 3] = ex2(zl[4 * q + 3] + s3); p[4 * q + 2] = ex2(zl[4 * q + 2] + s2); p[4 * q + 1] = ex2(zl[4 * q + 1] + s1); p[4 * q] = ex2(zl[4 * q] + s0);
        }
        Rsum += tile_total;
        const h8 pf0 = pack8(p[0], p[1], p[2], p[3], p[4], p[5], p[6], p[7]), pf1 = pack8(p[8], p[9], p[10], p[11], p[12], p[13], p[14], p[15]);
        const int q4 = (lane & 15) >> 2, pp = lane & 3, blk16 = (lane >> 4) & 1;
#pragma unroll
        for (int c = 0; c < 2; ++c)
#pragma unroll
            for (int s2 = 0; s2 < 2; ++s2) {
                const LAS unsigned char* a0 = vb + (16 * s2 + 4 * hh + q4) * SB_VPITCH + (32 * c + 16 * blk16) * 2 + 8 * pp;
                const h8 vf = tr_pair(a0, a0 + 8 * SB_VPITCH);
                oacc[c] = __builtin_amdgcn_mfma_f32_32x32x16_f16(vf, s2 ? pf1 : pf0, oacc[c], 0, 0, 0);
            }
        CFENCE();
        if (__ballot(Rsum > -160.f) == 0ull) break;
    }
    half_t* orow = YB + (R0 + t0 + r) * 512 + h * 64;
#pragma unroll
    for (int c = 0; c < 2; ++c)
#pragma unroll
        for (int q = 0; q < 4; ++q) *(h4*)(orow + 32 * c + 8 * q + 4 * hh) = pack4(oacc[c][4 * q], oacc[c][4 * q + 1], oacc[c][4 * q + 2], oacc[c][4 * q + 3]);
}

__device__ __forceinline__ void rms_job(Frame& F, const half_t* MIX, half_t* CKVN, const float* kvg, int job) {
    const int lane = opaque_lane(), row = job * 4 + (lane >> 4), c8 = (lane & 15) * 8;
    const h8 v = *(const h8*)(MIX + (size_t)row * NMIX + C_CKV + c8); float f[8], s = 0.f;
#pragma unroll
    for (int j = 0; j < 8; ++j) { f[j] = (float)v[j]; s += f[j] * f[j]; }
    s += __shfl_xor(s, 1); s += __shfl_xor(s, 2); s += __shfl_xor(s, 4); s += __shfl_xor(s, 8);
    const float rs = 1.f / sqrtf(s * (1.f / 128.f) + LN_EPS);
    const f32x4 g0 = *(const f32x4*)(kvg + c8), g1 = *(const f32x4*)(kvg + c8 + 4);
    *(h8*)(CKVN + (size_t)row * 128 + c8) = pack8(f[0] * rs * g0[0], f[1] * rs * g0[1], f[2] * rs * g0[2], f[3] * rs * g0[3], f[4] * rs * g1[0], f[5] * rs * g1[1], f[6] * rs * g1[2], f[7] * rs * g1[3]);
}
__device__ __forceinline__ void conv_job(Frame& F, const half_t* MIX, half_t* YC, const float* cw, int job) {
    const int lane = opaque_lane(), c8 = lane * 8, row0 = job * 8, tb = row0 & (S - 1);
    h8 cc[10], chv[10], cb[8];
#pragma unroll
    for (int i = 0; i < 10; ++i) { const int rr = (tb == 0 && i < 2) ? row0 : row0 - 2 + i;
        cc[i] = *(const h8*)(MIX + (size_t)rr * NMIX + C_CC + c8); chv[i] = *(const h8*)(MIX + (size_t)rr * NMIX + C_CH + c8); }
#pragma unroll
    for (int i = 0; i < 8; ++i) cb[i] = *(const h8*)(MIX + (size_t)(row0 + i) * NMIX + C_CB + c8);
    float w0[8], w1[8], w2[8];
#pragma unroll
    for (int j = 0; j < 8; ++j) { w0[j] = cw[c8 + j]; w1[j] = cw[512 + c8 + j]; w2[j] = cw[1024 + c8 + j]; }
    float z2[8], z1[8];
#pragma unroll
    for (int j = 0; j < 8; ++j) { z2[j] = tb == 0 ? 0.f : (float)cc[0][j] * (float)chv[0][j]; z1[j] = tb == 0 ? 0.f : (float)cc[1][j] * (float)chv[1][j]; }
#pragma unroll
    for (int i = 0; i < 8; ++i) { float o[8];
#pragma unroll
        for (int j = 0; j < 8; ++j) { const float z0 = (float)cc[i + 2][j] * (float)chv[i + 2][j]; o[j] = (float)cb[i][j] * (w0[j] * z2[j] + w1[j] * z1[j] + w2[j] * z0); z2[j] = z1[j]; z1[j] = z0; }
        *(h8*)(YC + (size_t)(row0 + i) * 512 + c8) = pack8(o[0], o[1], o[2], o[3], o[4], o[5], o[6], o[7]); }
}

__device__ __forceinline__ unsigned f2ord(float f) { const unsigned u = __float_as_uint(f); return (u & 0x80000000u) ? ~u : (u | 0x80000000u); }
template <int NR>
__device__ __forceinline__ void topk_select(const float* sc, int t, LAS unsigned short* out, int lane) {
    unsigned u[NR];
#pragma unroll
    for (int j = 0; j < NR; ++j) u[j] = ((const unsigned*)sc)[j * 64 + lane];
    CFENCE();
#pragma unroll
    for (int j = 0; j < NR; ++j) { const int s = j * 64 + lane; const unsigned v = u[j]; u[j] = s <= t ? ((v & 0x80000000u) ? ~v : (v | 0x80000000u)) : 0x007FFFFFu; }
    unsigned T = 0; int cge = 0;
    for (int bit = 31; bit >= 0; --bit) {
        const unsigned cand = T | (1u << bit); int c = 0;
#pragma unroll
        for (int j = 0; j < NR; ++j) { c += __builtin_popcountll(__ballot(u[j] >= cand));
            if ((j & 7) == 7) __builtin_amdgcn_sched_barrier(0); }
        if (c >= 256) { T = cand; cge = c; if (c == 256) break; }
    }
    if (cge == 256) {
        int base = 0;
        const unsigned long long below = (1ull << lane) - 1ull;
#pragma unroll
        for (int j = 0; j < NR; ++j) { const unsigned long long m = __ballot(u[j] >= T);
            if ((m >> lane) & 1ull) out[base + __builtin_popcountll(m & below)] = (unsigned short)(j * 64 + lane);
            base += __builtin_popcountll(m); if ((j & 7) == 7) __builtin_amdgcn_sched_barrier(0); }
    } else {
        int cgt = 0;
#pragma unroll
        for (int j = 0; j < NR; ++j) { cgt += __builtin_popcountll(__ballot(u[j] > T)); if ((j & 7) == 7) __builtin_amdgcn_sched_barrier(0); }
        int need = 256 - cgt, base = 0;
        const unsigned long long below = (1ull << lane) - 1ull;
#pragma unroll
        for (int j = 0; j < NR; ++j) {
            const unsigned long long mgt = __ballot(u[j] > T), meq = __ballot(u[j] == T);
            const int eqrank = __builtin_popcountll(meq & below); const bool take_eq = (u[j] == T) && (eqrank < need);
            const unsigned long long msel = mgt | __ballot(take_eq);
            const int neq = __builtin_popcountll(meq); need -= neq < need ? neq : need;
            if ((msel >> lane) & 1ull) out[base + __builtin_popcountll(msel & below)] = (unsigned short)(j * 64 + lane);
            base += __builtin_popcountll(msel);
        }
    }
}
__device__ __forceinline__ void idx_job(Frame& F, const half_t* MIX, unsigned short* IDX, float* SCR, int job) {
    const int lane = opaque_lane(), wave = F.wave, r = lane & 31, hk = lane >> 5;
    const int b = job >> 8, qt = job & 255, t0 = qt * 16;
    const size_t R0 = (size_t)b * S;
    LAS float* wl = (LAS float*)(F.lds + 65536);
    LAS unsigned short* ol = (LAS unsigned short*)(F.lds + 66048 + wave * 512);
    float* sc = SCR + (size_t)blockIdx.x * (16 * 4096);
    if (t0 + 15 < 256) {
#pragma unroll
        for (int qq = 0; qq < 2; ++qq) { const int t = t0 + 2 * wave + qq; unsigned short k4[4];
#pragma unroll
            for (int j = 0; j < 4; ++j) { const int s = 4 * lane + j; k4[j] = s <= t ? (unsigned short)s : (unsigned short)0xFFFF; }
            *(u32x2*)(IDX + (R0 + t) * 256 + 4 * lane) = (u32x2){(unsigned)k4[0] | ((unsigned)k4[1] << 16), (unsigned)k4[2] | ((unsigned)k4[3] << 16)}; }
        return;
    }
    const int tidj = wave * 64 + lane;
    if (tidj < 128) { const int q = tidj >> 3, hd = tidj & 7; wl[tidj] = (float)MIX[(R0 + t0 + q) * NMIX + C_IW + hd]; }
    const int blk = r >> 2, e = r & 3, tq = 2 * (blk & 1) + (blk >> 2), hd = 4 * ((blk >> 1) & 1) + e;
    const int Tb = (wave >> 2) * 2;
    h8 af[2][4];
#pragma unroll
    for (int T = 0; T < 2; ++T)
#pragma unroll
        for (int st = 0; st < 4; ++st) af[T][st] = *(const h8*)(MIX + (R0 + t0 + 4 * (Tb + T) + tq) * NMIX + C_IQ + hd * 64 + 16 * st + 8 * hk);
    __syncthreads();
    const int nkt = (t0 + 16 + 31) >> 5;
#ifndef REP_ST1
#define REP_ST1 1
#endif
#ifndef REP_ST2
#define REP_ST2 1
#endif
    _Pragma("nounroll") for (int rp1 = 0; rp1 < REP_ST1; ++rp1) {
    h8 bfn[4];
    if ((wave & 3) < nkt) {
#pragma unroll
        for (int st = 0; st < 4; ++st) bfn[st] = *(const h8*)(MIX + (R0 + (size_t)(wave & 3) * 32 + r) * NMIX + C_IK + 16 * st + 8 * hk); }
    for (int kt = (wave & 3); kt < nkt; kt += 4) {
        h8 bf[4];
#pragma unroll
        for (int st = 0; st < 4; ++st) bf[st] = bfn[st];
        if (kt + 4 < nkt) {
#pragma unroll
            for (int st = 0; st < 4; ++st) bfn[st] = *(const h8*)(MIX + (R0 + (size_t)(kt + 4) * 32 + r) * NMIX + C_IK + 16 * st + 8 * hk); }
#pragma unroll
        for (int T = 0; T < 2; ++T) {
            f32x16 acc;
#pragma unroll
            for (int i = 0; i < 16; ++i) acc[i] = 0.f;
#pragma unroll
            for (int st = 0; st < 4; ++st) acc = __builtin_amdgcn_mfma_f32_32x32x16_f16(af[T][st], bf[st], acc, 0, 0, 0);
#pragma unroll
            for (int q2 = 0; q2 < 2; ++q2) { const int ql = 4 * (Tb + T) + 2 * hk + q2;
                const f32x4 w0 = *(const LAS f32x4*)(wl + ql * 8), w1 = *(const LAS f32x4*)(wl + ql * 8 + 4); float sco = 0.f;
#pragma unroll
                for (int j = 0; j < 4; ++j) { sco += w0[j] * fmaxf(acc[q2 * 8 + j], 0.f); sco += w1[j] * fmaxf(acc[q2 * 8 + 4 + j], 0.f); }
                sc[ql * 4096 + kt * 32 + r] = sco; }
        }
    }
    }
    VM_WAIT(); __syncthreads();
#pragma unroll 1
    for (int qq = 0; qq < 2 * REP_ST2; ++qq) {
        const int ql = 2 * wave + (qq & 1), t = t0 + ql; const float* srow = sc + ql * 4096;
#ifdef TOPK_ONE
        topk_select<64>(srow, t, ol, lane);
#else
        if (t0 + 16 <= 1024) topk_select<16>(srow, t, ol, lane);
        else if (t0 + 16 <= 2048) topk_select<32>(srow, t, ol, lane);
        else if (t0 + 16 <= 3072) topk_select<48>(srow, t, ol, lane);
        else topk_select<64>(srow, t, ol, lane);
#endif
        LDS_WAIT(); CFENCE();
        *(u32x2*)(IDX + (R0 + t) * 256 + 4 * lane) = *(const LAS u32x2*)(ol + 4 * lane);
        LDS_WAIT(); CFENCE();
    }
    VM_WAIT(); __syncthreads();
}
constexpr int GA_PITCH = 272;
constexpr int GA_WAVE_BYTES = 10240;
constexpr int GA_TAB_OFF = 8 * GA_WAVE_BYTES;
__device__ __forceinline__ void ga_tables(Frame& F) {
    LAS float* rb = (LAS float*)(F.lds + GA_TAB_OFF); LAS unsigned char* t5 = F.lds + GA_TAB_OFF + 1024;
    if (F.tid < 256) rb[F.tid] = ((const float*)(F.ws + WS_SMALL + SM_RB))[F.tid];
    if (F.tid < 128) t5[F.tid] = T5.v[F.tid];
    __syncthreads();
}
__device__ __forceinline__ void ga_job(Frame& F, const half_t* MIX, const half_t* CKVN, const unsigned short* IDX, half_t* YA, int row) {
    const int lane = opaque_lane(), n16 = lane & 15, g = lane >> 4, t = row & (S - 1);
    const size_t R0 = (size_t)(row - t);
    LAS unsigned char* kvb = F.lds + F.wave * GA_WAVE_BYTES;
    LAS unsigned short* il = (LAS unsigned short*)(kvb + 8704);
    LAS float* al = (LAS float*)(kvb + 8704 + 512);
    const LAS float* rb = (const LAS float*)(F.lds + GA_TAB_OFF); const LAS unsigned char* t5 = F.lds + GA_TAB_OFF + 1024;
    *(LAS u32x2*)(il + 4 * lane) = *(const u32x2*)(IDX + (size_t)row * 256 + 4 * lane);
    h8 qf[4];
#pragma unroll
    for (int st = 0; st < 4; ++st) { h8 z;
#pragma unroll
        for (int j = 0; j < 8; ++j) z[j] = (half_t)0.f;
        qf[st] = n16 < 8 ? *(const h8*)(MIX + (size_t)row * NMIX + C_QL + n16 * 128 + 32 * st + 8 * g) : z; }
    f32x4 oacc[8];
#pragma unroll
    for (int nt = 0; nt < 8; ++nt) oacc[nt] = (f32x4){0.f, 0.f, 0.f, 0.f};
    float mrun = -1e30f, lsum = 0.f;
    LDS_WAIT(); CFENCE();
    h8 gr[8];
#pragma unroll
    for (int i = 0; i < 8; ++i) { unsigned key = il[4 * i + g]; key = key <= (unsigned)t ? key : 0u; gr[i] = *(const h8*)(CKVN + (R0 + key) * 128 + 8 * n16); }
#pragma unroll 1
    for (int ch = 0; ch < 8; ++ch) {
        CFENCE();
#pragma unroll
        for (int i = 0; i < 8; ++i) *(LAS h8*)(kvb + (4 * i + g) * GA_PITCH + 16 * n16) = gr[i];
        CFENCE();
        if (ch < 7) {
#pragma unroll
            for (int i = 0; i < 8; ++i) { unsigned key = il[32 * (ch + 1) + 4 * i + g]; key = key <= (unsigned)t ? key : 0u; gr[i] = *(const h8*)(CKVN + (R0 + key) * 128 + 8 * n16); }
        }
        f32x4 lacc[2];
#pragma unroll
        for (int u = 0; u < 2; ++u) { lacc[u] = (f32x4){0.f, 0.f, 0.f, 0.f};
#pragma unroll
            for (int st = 0; st < 4; ++st) { const h8 a = *(const LAS h8*)(kvb + (16 * u + n16) * GA_PITCH + (32 * st + 8 * g) * 2);
                lacc[u] = __builtin_amdgcn_mfma_f32_16x16x32_f16(a, qf[st], lacc[u], 0, 0, 0); } }
        float lg[8]; float cm = -1e30f;
#pragma unroll
        for (int u = 0; u < 2; ++u) { const u32x2 kk = *(const LAS u32x2*)(il + 32 * ch + 16 * u + 4 * g);
#pragma unroll
            for (int r = 0; r < 4; ++r) { const unsigned key = (r < 2 ? (kk[0] >> (16 * r)) : (kk[1] >> (16 * (r - 2)))) & 0xFFFFu;
                const bool ok = key <= (unsigned)t; const int dist = ok ? (t - (int)key) : 0; const int bucket = dist < 128 ? (int)t5[dist] : 31;
                const float v = ok ? lacc[u][r] + rb[bucket * 8 + (n16 & 7)] : -1e30f; lg[4 * u + r] = v; cm = fmaxf(cm, v); } }
        cm = fmaxf(cm, __shfl_xor(cm, 16)); cm = fmaxf(cm, __shfl_xor(cm, 32));
        const float mnew = fmaxf(mrun, cm), alpha = ex2(mrun - mnew); mrun = mnew;
        float p[8], ps = 0.f;
#pragma unroll
        for (int j = 0; j < 8; ++j) { p[j] = ex2(lg[j] - mnew); ps += p[j]; }
        lsum = lsum * alpha + ps;
        const h8 pf = pack8(p[0], p[1], p[2], p[3], p[4], p[5], p[6], p[7]);
        if (g == 0) al[n16] = alpha;
        LDS_WAIT(); CFENCE();
        const f32x4 av = *(const LAS f32x4*)(al + 4 * g);
#pragma unroll
        for (int nt = 0; nt < 8; ++nt) {
            oacc[nt] = oacc[nt] * av;
            const LAS unsigned char* a0 = kvb + (4 * g + ((lane >> 2) & 3)) * GA_PITCH + 32 * nt + 8 * (lane & 3);
            const h8 vf = tr_pair(a0, a0 + 16 * GA_PITCH);
            oacc[nt] = __builtin_amdgcn_mfma_f32_16x16x32_f16(pf, vf, oacc[nt], 0, 0, 0);
        }
        CFENCE();
    }
    lsum += __shfl_xor(lsum, 16); lsum += __shfl_xor(lsum, 32);
    if (g == 0) al[n16] = 1.f / lsum;
    LDS_WAIT(); CFENCE();
    const f32x4 iv = *(const LAS f32x4*)(al + 4 * g);
    if (g < 2) {
#pragma unroll
        for (int nt = 0; nt < 8; ++nt)
#pragma unroll
            for (int r = 0; r < 4; ++r) *(LAS half_t*)(kvb + ((4 * g + r) * 128 + 16 * nt + n16) * 2) = (half_t)(oacc[nt][r] * iv[r]);
    }
    LDS_WAIT(); CFENCE();
#pragma unroll
    for (int i = 0; i < 2; ++i) *(h8*)(YA + (size_t)row * 1024 + (i * 64 + lane) * 8) = *(const LAS h8*)(kvb + (i * 64 + lane) * 16);
    LDS_WAIT(); CFENCE();
}

__device__ __forceinline__ void xa_job(Frame& F, const half_t* XQ, const half_t* XK, const half_t* XVT, half_t* XO, int job) {
    const int lane = opaque_lane(), r = lane & 31, hk = lane >> 5;
    const int qb = job & 127, hd = (job >> 7) & 3, b = job >> 9;
    const size_t qrow = (size_t)b * S + qb * 32 + r;
    h8 qf[8];
#pragma unroll
    for (int st = 0; st < 8; ++st) qf[st] = *(const h8*)(XQ + qrow * 512 + hd * 128 + 16 * st + 8 * hk);
    f32x16 oacc[4];
#pragma unroll
    for (int c = 0; c < 4; ++c)
#pragma unroll
        for (int i = 0; i < 16; ++i) oacc[c][i] = 0.f;
    float mrun = -1e30f, lsum = 0.f;
#pragma unroll 1
    for (int kt = 0; kt < 8; ++kt) {
        f32x16 sacc;
#pragma unroll
        for (int i = 0; i < 16; ++i) sacc[i] = 0.f;
#pragma unroll
        for (int st = 0; st < 8; ++st) { const h8 kf = *(const h8*)(XK + ((size_t)b * 256 + kt * 32 + r) * 512 + hd * 128 + 16 * st + 8 * hk);
            sacc = __builtin_amdgcn_mfma_f32_32x32x16_f16(kf, qf[st], sacc, 0, 0, 0); }
        float cm = sacc[0];
#pragma unroll
        for (int i = 1; i < 16; ++i) cm = fmaxf(cm, sacc[i]);
        cm = fmaxf(cm, __shfl_xor(cm, 32));
        const float mnew = fmaxf(mrun, cm), alpha = ex2(mrun - mnew); mrun = mnew;
        float p[16], ps = 0.f;
#pragma unroll
        for (int i = 0; i < 16; ++i) { p[i] = ex2(sacc[i] - mnew); ps += p[i]; }
        lsum = lsum * alpha + ps;
        const h8 pf0 = pack8(p[0], p[1], p[2], p[3], p[4], p[5], p[6], p[7]), pf1 = pack8(p[8], p[9], p[10], p[11], p[12], p[13], p[14], p[15]);
#pragma unroll
        for (int c = 0; c < 4; ++c) {
#pragma unroll
            for (int i = 0; i < 16; ++i) oacc[c][i] *= alpha;
#pragma unroll
            for (int s2 = 0; s2 < 2; ++s2) { const h8 vf = *(const h8*)(XVT + (size_t)(hd * 128 + 32 * c + r) * 2048 + b * 256 + kt * 32 + 16 * s2 + 8 * hk);
                oacc[c] = __builtin_amdgcn_mfma_f32_32x32x16_f16(vf, s2 ? pf1 : pf0, oacc[c], 0, 0, 0); }
        }
    }
    lsum += __shfl_xor(lsum, 32);
    const float inv = 1.f / lsum;
    half_t* orow = XO + qrow * 512 + hd * 128;
#pragma unroll
    for (int c = 0; c < 4; ++c)
#pragma unroll
        for (int q = 0; q < 4; ++q) *(h4*)(orow + 32 * c + 8 * q + 4 * hk) = pack4(oacc[c][4 * q] * inv, oacc[c][4 * q + 1] * inv, oacc[c][4 * q + 2] * inv, oacc[c][4 * q + 3] * inv);
}
#ifndef MK_N_LAUNCHES
#define MK_N_LAUNCHES 1
#endif
#ifndef REP_GEMM
#define REP_GEMM 1
#endif
#ifndef REP_M2
#define REP_M2 1
#endif
#ifndef REP_FIN
#define REP_FIN 1
#endif
#ifndef REP_IDX
#define REP_IDX 1
#endif
#ifndef REP_SB
#define REP_SB 1
#endif
#ifndef REP_M3
#define REP_M3 1
#endif
#ifndef REP_XA
#define REP_XA 1
#endif
#ifndef REP_MISC
#define REP_MISC 1
#endif
constexpr int NSLOT = 20, NPHASE = 1 + DEPTH * NSLOT;
struct Args { const float* in[18]; float* out; unsigned char* ws; int ph_lo, ph_hi; };
__global__ void __launch_bounds__(NWAVES * 64, 2) fwd(Args args) {
    extern __shared__ __attribute__((aligned(16))) unsigned char lds_raw[];
    Frame F;
    F.lds = (LAS unsigned char*)lds_raw;
    F.wave = __builtin_amdgcn_readfirstlane((int)threadIdx.x >> 6); F.lane = opaque_lane(); F.tid = F.wave * 64 + F.lane;
    F.G = gridDim.x; { const int bx = blockIdx.x; F.vcu = (F.G % 8 == 0) ? (bx % 8) * (F.G / 8) + bx / 8 : bx; }
    F.ws = args.ws; F.dout = (unsigned char*)args.out;
    unsigned char* const ws = args.ws;
    for (int u = F.tid; u < (LDS_BYTES - LDSCTL_OFF) / 4; u += NWAVES * 64) ((LAS unsigned*)(F.lds + LDSCTL_OFF))[u] = 0u;
    __syncthreads();
    const int lo = args.ph_lo, hi = args.ph_hi;
    XcdBarrier bar; bar.bar = (unsigned*)(ws + WS_CTL) + CW_BAR; bar.x = 0; bar.st = nullptr; bar.wave = F.wave;
    if (hi - lo > 1) bar = xcd_barrier_post((unsigned*)(ws + WS_CTL) + CW_BAR, (volatile LAS unsigned*)(F.lds + MISC_OFF) + 8, F.wave);
#define RUN(gp) ((gp) >= lo && (gp) < hi && ((F.lane = opaque_lane()), (F.tid = F.wave * 64 + F.lane), true))
#define SEAM(gp) do { if ((gp) >= lo && (gp) + 1 < hi) xcd_barrier(bar); } while (0)
#define REPL(n) _Pragma("nounroll") for (int rep = 0; rep < (n); ++rep)

    if (RUN(0)) REPL(REP_MISC) {
        F.x_in = args.in[0]; F.mem = args.in[1]; F.ln_g = args.in[2]; F.ln_b = args.in[3]; F.ffn_w_in = args.in[4]; F.ffn_w_out = args.in[5]; F.w_mix_in = args.in[6]; F.b_gate = args.in[7];
        F.kv_g = args.in[8]; F.w_uk = args.in[9]; F.w_uv = args.in[10]; F.conv_w = args.in[11]; F.w_branch = args.in[12]; F.w_mix_out = args.in[13]; F.xa_wq = args.in[14]; F.xa_wkv = args.in[15];
        F.xa_wo = args.in[16]; F.rel_bias = args.in[17];
        for (int l = 0; l < DEPTH; ++l) p_prep(F, l);
        p_x_to_half(F);
    }
    SEAM(0);

    half_t* const X = (half_t*)(ws + WS_X);
    half_t* const MEMH = (half_t*)(ws + WS_MEMH); half_t* const MEMP = (half_t*)(ws + WS_MEMP);
    half_t* const XK = (half_t*)(ws + WS_XK); half_t* const XVT = (half_t*)(ws + WS_XVT);
    half_t* const CKVN = (half_t*)(ws + WS_CKVN); unsigned short* const IDX = (unsigned short*)(ws + WS_IDX);
    half_t* const MIX = (half_t*)(ws + WS_BIG); half_t* const H = (half_t*)(ws + WS_BIG); half_t* const VBIG = (half_t*)(ws + WS_BIG);
    half_t* const XQ = (half_t*)(ws + WS_BIG); half_t* const XO = (half_t*)(ws + WS_BIG + 32 * MiB);
    half_t* const YA = (half_t*)(F.dout + DO_YA); half_t* const YB = (half_t*)(F.dout + DO_YB); half_t* const YC = (half_t*)(F.dout + DO_YC); half_t* const MG = (half_t*)(F.dout + DO_MG);
    float* const SCR = (float*)(F.dout + DO_SCR);
    half_t* const VOUT = (half_t*)(ws + WS_BIG + 184 * MiB);
    const float* const SMf = (const float*)(ws + WS_SMALL);
    const int cid = (int)blockIdx.x;

    for (int l = 0; l < DEPTH; ++l) {
        const int g0 = 1 + l * NSLOT;
        unsigned char* const wl = ws + WS_WL + (size_t)l * WL_STRIDE;
        half_t* const WFIN = (half_t*)(wl + WL_WFIN); half_t* const WFOUT = (half_t*)(wl + WL_WFOUT); half_t* const WMIX = (half_t*)(wl + WL_WMIX);
        half_t* const WBRA = (half_t*)(wl + WL_WBRA); half_t* const WBRB = (half_t*)(wl + WL_WBRB); half_t* const WBRC = (half_t*)(wl + WL_WBRC);
        half_t* const WMO = (half_t*)(wl + WL_WMO); half_t* const WXQ = (half_t*)(wl + WL_WXQ); half_t* const WXKV = (half_t*)(wl + WL_WXKV); half_t* const WXO = (half_t*)(wl + WL_WXO);
        for (int which = 0; which < 2; ++which) {
            const int sb = g0 + (which ? 17 : 0);
            if (RUN(sb)) REPL(REP_GEMM) {
                _Pragma("nounroll") for (int rf = 0; rf < REP_FIN; ++rf)
                { pg8::Gemm g{X, WFIN + (size_t)which * 5632 * 1024, M, 2 * DFF, D}; pg8::StaticOrder So; So.init(M, 2 * DFF, F.G, cid);
                  pg8::EpiSwiGLU E{H, DFF}; pg8::gemm_phase(F.lds, g, So, E, F.wave); }
                if (which == 0) {
                    { pg8::Gemm g{MEMH, WXKV, NB * MEM, 512, D}; pg8::StaticOrder So; So.init(NB * MEM, 512, F.G, cid);
                      pg8::EpiH E{XK, 512, nullptr, 0, 0}; pg8::gemm_phase(F.lds, g, So, E, F.wave); }
                    { pg8::Gemm g{WXKV + (size_t)512 * 1024, MEMP, 512, NB * MEM, D}; pg8::StaticOrder So; So.init(512, NB * MEM, F.G, cid);
                      pg8::EpiH E{XVT, NB * MEM, nullptr, 0, 0}; pg8::gemm_phase(F.lds, g, So, E, F.wave); }
                }
            }
            SEAM(sb);
            if (RUN(sb + 1)) REPL(REP_GEMM) { pg8::Gemm g{H, WFOUT + (size_t)which * 1024 * DFF, M, D, DFF}; pg8::StaticOrder So; So.init(M, D, F.G, cid);
                pg8::EpiRes E{X, VOUT, 0.5f}; pg8::gemm_phase(F.lds, g, So, E, F.wave); }
            SEAM(sb + 1);
            if (RUN(sb + 2)) REPL(REP_MISC) { const int li = which ? 3 : 0; p_ln(F, VOUT, SMf + SM_LNG / 4 + (size_t)(l * 4 + li) * D, SMf + SM_LNB / 4 + (size_t)(l * 4 + li) * D, (which == 1 && l == DEPTH - 1) ? (float*)F.dout : nullptr); }
            SEAM(sb + 2);
            if (which == 0) {
                for (int c = 0; c < NCHUNK; ++c) {
                    const int gm = g0 + 3 + 4 * c;
                    if (RUN(gm)) REPL(REP_GEMM) { pg8::Gemm g{X + (size_t)c * CH_ROWS * D, WMIX, CH_ROWS, NMIX, D}; pg8::StaticOrder So; So.init(CH_ROWS, NMIX, F.G, cid);
                        pg8::EpiH E{MIX, NMIX, (const float*)(wl + WL_BIAS), 18, 30}; pg8::gemm_phase(F.lds, g, So, E, F.wave); }
                    SEAM(gm);
                    if (RUN(gm + 1)) REPL(REP_M2) {
                        _Pragma("nounroll") for (int rp = 0; rp < REP_IDX; ++rp)
                        for (int k = F.vcu; k < CH_B * 256; k += F.G) idx_job(F, MIX, IDX, SCR, ((k & 3) << 8) | (255 - (k >> 2)));
                        F.lane = opaque_lane(); F.tid = F.wave * 64 + F.lane;
                        _Pragma("nounroll") for (int rp = 0; rp < REP_SB; ++rp)
                        for (int j = F.vcu * NWAVES + F.wave; j < CH_B * 8 * 128; j += F.G * NWAVES) sb_job(F, MIX, YB, j);
                        F.lane = opaque_lane(); F.tid = F.wave * 64 + F.lane;
                        for (int j = F.vcu * NWAVES + F.wave; j < CH_ROWS / 4; j += F.G * NWAVES) rms_job(F, MIX, CKVN, SMf + SM_KVG / 4 + (size_t)l * 128, j);
                        for (int j = F.vcu * NWAVES + F.wave; j < CH_ROWS / 8; j += F.G * NWAVES) conv_job(F, MIX, YC, SMf + SM_CONV / 4 + (size_t)l * 3 * 512, j);
                    }
                    SEAM(gm + 1);
                    if (RUN(gm + 2)) REPL(REP_M3) {
                        ga_tables(F);
                        const int per = (CH_ROWS + F.G - 1) / F.G, r0 = F.vcu * per, r1 = (r0 + per) < CH_ROWS ? (r0 + per) : CH_ROWS;
                        for (int row = r0 + F.wave; row < r1; row += NWAVES) ga_job(F, MIX, CKVN, IDX, YA, row);
                    }
                    SEAM(gm + 2);
                    if (RUN(gm + 3)) REPL(REP_GEMM) {
                        half_t* mgc = MG + (size_t)c * CH_ROWS * D;
                        { pg8::Gemm g{YA, WBRA, CH_ROWS, D, 1024}; pg8::StaticOrder So; So.init(CH_ROWS, D, F.G, cid); pg8::EpiGate<true> E{MIX + C_G, NMIX, mgc}; pg8::gemm_phase(F.lds, g, So, E, F.wave); }
                        { pg8::Gemm g{YB, WBRB, CH_ROWS, D, 512}; pg8::StaticOrder So; So.init(CH_ROWS, D, F.G, cid); pg8::EpiGate<false> E{MIX + C_G + 1024, NMIX, mgc}; pg8::gemm_phase(F.lds, g, So, E, F.wave); }
                        { pg8::Gemm g{YC, WBRC, CH_ROWS, D, 512}; pg8::StaticOrder So; So.init(CH_ROWS, D, F.G, cid); pg8::EpiGate<false> E{MIX + C_G + 2048, NMIX, mgc}; pg8::gemm_phase(F.lds, g, So, E, F.wave); }
                    }
                    SEAM(gm + 3);
                }
                if (RUN(g0 + 11)) REPL(REP_GEMM) { pg8::Gemm g{MG, WMO, M, D, D}; pg8::StaticOrder So; So.init(M, D, F.G, cid); pg8::EpiRes E{X, VBIG, 1.0f}; pg8::gemm_phase(F.lds, g, So, E, F.wave); }
                SEAM(g0 + 11);
                if (RUN(g0 + 12)) REPL(REP_MISC) p_ln(F, VBIG, SMf + SM_LNG / 4 + (size_t)(l * 4 + 1) * D, SMf + SM_LNB / 4 + (size_t)(l * 4 + 1) * D, nullptr);
                SEAM(g0 + 12);
                if (RUN(g0 + 13)) REPL(REP_GEMM) { pg8::Gemm g{X, WXQ, M, 512, D}; pg8::StaticOrder So; So.init(M, 512, F.G, cid); pg8::EpiH E{XQ, 512, nullptr, 0, 0}; pg8::gemm_phase(F.lds, g, So, E, F.wave); }
                SEAM(g0 + 13);
                if (RUN(g0 + 14)) REPL(REP_XA) { for (int j = F.vcu * NWAVES + F.wave; j < NB * 4 * 128; j += F.G * NWAVES) xa_job(F, XQ, XK, XVT, XO, j); }
                SEAM(g0 + 14);
                if (RUN(g0 + 15)) REPL(REP_GEMM) { pg8::Gemm g{XO, WXO, M, D, 512}; pg8::StaticOrder So; So.init(M, D, F.G, cid); pg8::EpiRes E{X, VOUT, 1.0f}; pg8::gemm_phase(F.lds, g, So, E, F.wave); }
                SEAM(g0 + 15);
                if (RUN(g0 + 16)) REPL(REP_MISC) p_ln(F, VOUT, SMf + SM_LNG / 4 + (size_t)(l * 4 + 2) * D, SMf + SM_LNB / 4 + (size_t)(l * 4 + 2) * D, nullptr);
                SEAM(g0 + 16);
            }
        }
    }
#undef RUN
#undef SEAM
#undef REPL
}

extern "C" void kernel_launch(void* const* d_in, const int* in_sizes, int n_in, void* d_out, int out_size, void* d_ws, size_t ws_size, hipStream_t stream) {
    static int grid = 0;
    if (grid == 0) {
        if (n_in != 18 || out_size != M * D || ws_size < WS_END) { fprintf(stderr, "kernel_launch: unexpected shapes (n_in %d out %d ws %zu need %zu)\n", n_in, out_size, ws_size, (size_t)WS_END); grid = -1; return; }
        int dev = 0, cus = 0, per_cu = 0;
        if (hipGetDevice(&dev) != hipSuccess || hipDeviceGetAttribute(&cus, hipDeviceAttributeMultiprocessorCount, dev) != hipSuccess) { grid = -1; return; }
        if (hipFuncSetAttribute((const void*)fwd, hipFuncAttributeMaxDynamicSharedMemorySize, LDS_BYTES) != hipSuccess) { fprintf(stderr, "kernel_launch: hipFuncSetAttribute failed\n"); grid = -1; return; }
        if (hipOccupancyMaxActiveBlocksPerMultiprocessor(&per_cu, (const void*)fwd, NWAVES * 64, LDS_BYTES) != hipSuccess || per_cu < 1) { fprintf(stderr, "kernel_launch: occupancy query says %d\n", per_cu); }
        (void)hipGetLastError();
        grid = cus;
    }
    if (grid < 0) return;
    if (hipMemsetAsync((char*)d_ws + WS_CTL, 0, CTL_ZERO_BYTES, stream) != hipSuccess) return;
    Args a{};
    for (int i = 0; i < 18; ++i) a.in[i] = (const float*)d_in[i];
    a.out = (float*)d_out; a.ws = (unsigned char*)d_ws;
#if MK_N_LAUNCHES == 1
    a.ph_lo = 0; a.ph_hi = NPHASE;
    hipLaunchKernelGGL(fwd, dim3(grid), dim3(NWAVES * 64), LDS_BYTES, stream, a);
#else
    for (int p = 0; p < NPHASE; ++p) { a.ph_lo = p; a.ph_hi = p + 1; hipLaunchKernelGGL(fwd, dim3(grid), dim3(NWAVES * 64), LDS_BYTES, stream, a); }
#endif
}
```
